# Optimizing an MI355X kernel written in HIP

```python
import math
import jax
import jax.numpy as jnp
from jax import lax
import numpy as np

D_MODEL = 4096
BATCH = 4
SEQ = 4096
DEPTH = 1

D_MIX = D_MODEL
MLSTM_WIDTH = D_MIX // 2
MLSTM_HEADS = 4
MLSTM_V_DIM = MLSTM_WIDTH // MLSTM_HEADS
MLSTM_QK_DIM = MLSTM_V_DIM // 2
MLSTM_QK_WIDTH = MLSTM_HEADS * MLSTM_QK_DIM
MLSTM_CHUNK = 64
CONV_WIDTH = 4
NSA_WIDTH = D_MIX - MLSTM_WIDTH
NSA_HEAD_DIM = 128
NSA_HEADS = NSA_WIDTH // NSA_HEAD_DIM
NSA_KV_GROUPS = 4
NSA_HPG = NSA_HEADS // NSA_KV_GROUPS
NSA_KV_WIDTH = NSA_KV_GROUPS * NSA_HEAD_DIM
CMP_BLOCK = 32
CMP_STRIDE = 16
SLC_BLOCK = 64
SLC_TOP_N = 16
WINDOW = 512
QUERY_BLOCK = 64
FORCE_BONUS = 1000.0
REL_BUCKETS = 32
REL_MAX_EXACT = REL_BUCKETS // 2
REL_MAX_DISTANCE = 1024
RMS_EPS = 1e-6
NEG_LOGIT = -1e30

SPLIT_SIZES = (
    MLSTM_QK_WIDTH, MLSTM_QK_WIDTH, MLSTM_WIDTH, MLSTM_WIDTH, MLSTM_WIDTH,
    MLSTM_HEADS, MLSTM_HEADS,
    NSA_WIDTH,
    NSA_KV_WIDTH, NSA_KV_WIDTH,
    NSA_KV_WIDTH, NSA_KV_WIDTH,
    NSA_KV_WIDTH, NSA_KV_WIDTH,
    3 * NSA_HEADS,
    NSA_WIDTH,
)
IN_COLS = sum(SPLIT_SIZES)

kernel_name = "hymba_mlstm_nsa_layer"


def _rmsnorm(x, gain):
    xf = x.astype(jnp.float32)
    y = xf * lax.rsqrt(jnp.mean(xf * xf, axis=-1, keepdims=True) + RMS_EPS)
    return (y * gain.astype(jnp.float32)).astype(x.dtype)


def _rel_bucket(dist):
    n = jnp.maximum(dist, 0)
    nf = jnp.maximum(n, REL_MAX_EXACT).astype(jnp.float32)
    large = REL_MAX_EXACT + (jnp.log(nf / REL_MAX_EXACT) / math.log(REL_MAX_DISTANCE / REL_MAX_EXACT)
                             * (REL_BUCKETS - REL_MAX_EXACT)).astype(jnp.int32)
    large = jnp.minimum(large, REL_BUCKETS - 1)
    return jnp.where(n < REL_MAX_EXACT, n, large)


def _causal_conv(u, w):
    c = u.shape[-1]
    return lax.conv_general_dilated(
        u, w[:, None, :].astype(u.dtype), window_strides=(1,), padding=[(CONV_WIDTH - 1, 0)],
        dimension_numbers=("NWC", "WIO", "NWC"), feature_group_count=c)


def _mlstm(q, k, v, i_pre, f_pre):
    b_, t_, nh, dqk = q.shape
    dv = v.shape[-1]
    L = MLSTM_CHUNK
    nc = t_ // L
    k = k * (dqk ** -0.5)
    log_f = jax.nn.log_sigmoid(f_pre)

    def to_chunks(a):
        return a.reshape(b_, nc, L, nh, a.shape[-1]).transpose(1, 0, 3, 2, 4)

    def gate_chunks(a):
        return a.reshape(b_, nc, L, nh).transpose(1, 0, 3, 2)

    causal = jnp.tril(jnp.ones((L, L), dtype=bool))

    def step(carry, inp):
        c_st, n_st, m_st = carry
        qc, kc, vc, ic, lfc = inp
        bcum = jnp.cumsum(lfc, axis=-1)
        g = bcum[..., -1]
        dlog = jnp.where(causal, bcum[..., :, None] - bcum[..., None, :] + ic[..., None, :], -jnp.inf)
        m_inter = bcum + m_st[..., None]
        m_t = jnp.maximum(m_inter, jnp.max(dlog, axis=-1))
        s = jnp.einsum('bhld,bhsd->bhls', qc, kc) * jnp.exp(dlog - m_t[..., None])
        inter = jnp.exp(m_inter - m_t)
        num = jnp.einsum('bhls,bhsv->bhlv', s, vc) + inter[..., None] * jnp.einsum('bhld,bhdv->bhlv', qc, c_st)
        qn = jnp.sum(s, axis=-1) + inter * jnp.einsum('bhld,bhd->bhl', qc, n_st)
        h = num / jnp.maximum(jnp.abs(qn), jnp.exp(-m_t))[..., None]
        w_log = g[..., None] - bcum + ic
        m_next = jnp.maximum(g + m_st, jnp.max(w_log, axis=-1))
        wts = jnp.exp(w_log - m_next[..., None])
        keep = jnp.exp(g + m_st - m_next)
        c_new = keep[..., None, None] * c_st + jnp.einsum('bhl,bhld,bhlv->bhdv', wts, kc, vc)
        n_new = keep[..., None] * n_st + jnp.einsum('bhl,bhld->bhd', wts, kc)
        return (c_new, n_new, m_next), h

    init = (jnp.zeros((b_, nh, dqk, dv), jnp.float32),
            jnp.zeros((b_, nh, dqk), jnp.float32),
            jnp.zeros((b_, nh), jnp.float32))
    xs = (to_chunks(q), to_chunks(k), to_chunks(v), gate_chunks(i_pre), gate_chunks(log_f))
    _, hs = lax.scan(step, init, xs)
    return hs.transpose(1, 0, 3, 2, 4).reshape(b_, t_, nh, dv)


def _compress(blocks, pos, w1, w2):
    hid = jax.nn.silu(jnp.einsum('bnlgd,lde->bnge', blocks + pos[None, None, :, None, :], w1))
    return jnp.einsum('bnge,ef->bngf', hid, w2)


def _nsa(q, ck, cv, sk, sv, wk, wv, gate_pre,
         cmp_k_pos, cmp_k_w1, cmp_k_w2, cmp_v_pos, cmp_v_w1, cmp_v_w2, rel_bias):
    b_, t_, _ = q.shape
    G, HPG, DH = NSA_KV_GROUPS, NSA_HPG, NSA_HEAD_DIM
    scale = DH ** -0.5
    q = q.reshape(b_, t_, G, HPG, DH)
    ck, cv, sk, sv, wk, wv = [a.reshape(b_, t_, G, DH) for a in (ck, cv, sk, sv, wk, wv)]
    tpos = jnp.arange(t_, dtype=jnp.int32)

    n_cmp = (t_ - CMP_BLOCK) // CMP_STRIDE + 1
    blk_idx = np.arange(n_cmp)[:, None] * CMP_STRIDE + np.arange(CMP_BLOCK)[None, :]
    k_cmp = _compress(ck[:, blk_idx], cmp_k_pos, cmp_k_w1, cmp_k_w2)
    v_cmp = _compress(cv[:, blk_idx], cmp_v_pos, cmp_v_w1, cmp_v_w2)
    blk_end = jnp.asarray(np.arange(n_cmp) * CMP_STRIDE + CMP_BLOCK - 1, dtype=jnp.int32)
    dist_c = tpos[:, None] - blk_end[None, :]
    mask_c = dist_c >= 0
    bias_c = rel_bias[_rel_bucket(dist_c)].transpose(2, 0, 1).reshape(G, HPG, t_, n_cmp)
    logit_c = jnp.einsum('btghd,bngd->bghtn', q, k_cmp, preferred_element_type=jnp.float32) * scale + bias_c
    p_c = jax.nn.softmax(jnp.where(mask_c, logit_c, NEG_LOGIT), axis=-1) * mask_c
    o_cmp = jnp.einsum('bghtn,bngd->btghd', p_c.astype(v_cmp.dtype), v_cmp)

    n_slc = t_ // SLC_BLOCK
    cs = np.arange(n_cmp) * CMP_STRIDE
    ss = np.arange(n_slc) * SLC_BLOCK
    cover = np.clip(np.minimum(cs[:, None] + CMP_BLOCK, ss[None, :] + SLC_BLOCK)
                    - np.maximum(cs[:, None], ss[None, :]), 0, None) / CMP_BLOCK
    cover = jnp.asarray(cover, dtype=jnp.float32)
    p_slc = jnp.einsum('bghtn,nj->bgtj', p_c, cover)
    cur = tpos // SLC_BLOCK
    jb = jnp.arange(n_slc, dtype=jnp.int32)
    valid = jb[None, :] <= cur[:, None]
    forced = (jb[None, :] == 0) | (jb[None, :] == cur[:, None]) | (jb[None, :] == cur[:, None] - 1)
    score = jnp.where(valid, p_slc + jnp.where(forced, FORCE_BONUS, 0.0), -1.0)
    n_sel = min(SLC_TOP_N, n_slc)
    _, sel_idx = lax.top_k(score, n_sel)

    ks = sk.reshape(b_, n_slc, SLC_BLOCK, G, DH).transpose(0, 3, 1, 2, 4)
    vs = sv.reshape(b_, n_slc, SLC_BLOCK, G, DH).transpose(0, 3, 1, 2, 4)
    wk_pad = jnp.pad(wk, ((0, 0), (WINDOW, 0), (0, 0), (0, 0)))
    wv_pad = jnp.pad(wv, ((0, 0), (WINDOW, 0), (0, 0), (0, 0)))
    rb = rel_bias.T.reshape(G, HPG, REL_BUCKETS)
    bi = jnp.arange(b_)[:, None, None, None]
    gi = jnp.arange(G)[None, :, None, None]
    gi5 = jnp.arange(G)[None, :, None, None, None]
    hi5 = jnp.arange(HPG)[None, None, :, None, None]
    in_blk = jnp.arange(SLC_BLOCK, dtype=jnp.int32)
    win_off = jnp.arange(QUERY_BLOCK + WINDOW, dtype=jnp.int32)

    def block_fn(qb):
        t0 = qb * QUERY_BLOCK
        q_blk = lax.dynamic_slice_in_dim(q, t0, QUERY_BLOCK, axis=1)
        t_blk = t0 + jnp.arange(QUERY_BLOCK, dtype=jnp.int32)
        sel = lax.dynamic_slice_in_dim(sel_idx, t0, QUERY_BLOCK, axis=2)
        k_sel = ks[bi, gi, sel].reshape(b_, G, QUERY_BLOCK, n_sel * SLC_BLOCK, DH)
        v_sel = vs[bi, gi, sel].reshape(b_, G, QUERY_BLOCK, n_sel * SLC_BLOCK, DH)
        s_pos = (sel[..., None] * SLC_BLOCK + in_blk).reshape(b_, G, QUERY_BLOCK, n_sel * SLC_BLOCK)
        dist_s = t_blk[None, None, :, None] - s_pos
        bias_s = rb[gi5, hi5, _rel_bucket(dist_s)[:, :, None]]
        logit_s = jnp.einsum('bqghd,bgqkd->bghqk', q_blk, k_sel, preferred_element_type=jnp.float32) * scale + bias_s
        p_s = jax.nn.softmax(jnp.where((dist_s >= 0)[:, :, None], logit_s, NEG_LOGIT), axis=-1)
        o_s = jnp.einsum('bghqk,bgqkd->bqghd', p_s.astype(v_sel.dtype), v_sel)
        k_win = lax.dynamic_slice_in_dim(wk_pad, t0, QUERY_BLOCK + WINDOW, axis=1)
        v_win = lax.dynamic_slice_in_dim(wv_pad, t0, QUERY_BLOCK + WINDOW, axis=1)
        w_pos = t0 - WINDOW + win_off
        dist_w = t_blk[:, None] - w_pos[None, :]
        mask_w = (dist_w >= 0) & (dist_w < WINDOW) & (w_pos[None, :] >= 0)
        bias_w = rel_bias[_rel_bucket(dist_w)].transpose(2, 0, 1).reshape(G, HPG, QUERY_BLOCK, QUERY_BLOCK + WINDOW)
        logit_w = jnp.einsum('bqghd,bkgd->bghqk', q_blk, k_win, preferred_element_type=jnp.float32) * scale + bias_w
        p_w = jax.nn.softmax(jnp.where(mask_w, logit_w, NEG_LOGIT), axis=-1)
        o_w = jnp.einsum('bghqk,bkgd->bqghd', p_w.astype(v_win.dtype), v_win)
        return o_s, o_w

    o_slc, o_win = lax.map(block_fn, jnp.arange(t_ // QUERY_BLOCK, dtype=jnp.int32))
    o_slc = o_slc.transpose(1, 0, 2, 3, 4, 5).reshape(b_, t_, G, HPG, DH)
    o_win = o_win.transpose(1, 0, 2, 3, 4, 5).reshape(b_, t_, G, HPG, DH)

    gates = jax.nn.sigmoid(gate_pre.astype(jnp.float32)).reshape(b_, t_, G, HPG, 3)
    o = gates[..., 0:1] * o_cmp + gates[..., 1:2] * o_slc + gates[..., 2:3] * o_win
    return o.reshape(b_, t_, NSA_WIDTH)


def setup_inputs(seed: int = 0) -> dict:
    key = jax.random.key(seed)
    ks = jax.random.split(key, 16)
    nrm = jax.random.normal
    f32 = jnp.float32
    return {
        "x": nrm(ks[0], (BATCH, SEQ, D_MODEL), f32),
        "norm_gain": 1.0 + 0.02 * nrm(ks[1], (D_MODEL,), f32),
        "w_in": nrm(ks[2], (D_MODEL, IN_COLS), f32) * D_MODEL ** -0.5,
        "w_conv": nrm(ks[3], (CONV_WIDTH, 2 * MLSTM_QK_WIDTH), f32) * CONV_WIDTH ** -0.5,
        "b_igate": 0.1 * nrm(ks[4], (MLSTM_HEADS,), f32),
        "b_fgate": 3.0 + 0.5 * nrm(ks[5], (MLSTM_HEADS,), f32),
        "mlstm_norm_gain": 1.0 + 0.02 * nrm(ks[6], (MLSTM_WIDTH,), f32),
        "cmp_k_pos": 0.1 * nrm(ks[7], (CMP_BLOCK, NSA_HEAD_DIM), f32),
        "cmp_k_w1": nrm(ks[8], (CMP_BLOCK, NSA_HEAD_DIM, NSA_HEAD_DIM), f32) * (CMP_BLOCK * NSA_HEAD_DIM) ** -0.5,
        "cmp_k_w2": nrm(ks[9], (NSA_HEAD_DIM, NSA_HEAD_DIM), f32) * NSA_HEAD_DIM ** -0.5,
        "cmp_v_pos": 0.1 * nrm(ks[10], (CMP_BLOCK, NSA_HEAD_DIM), f32),
        "cmp_v_w1": nrm(ks[11], (CMP_BLOCK, NSA_HEAD_DIM, NSA_HEAD_DIM), f32) * (CMP_BLOCK * NSA_HEAD_DIM) ** -0.5,
        "cmp_v_w2": nrm(ks[12], (NSA_HEAD_DIM, NSA_HEAD_DIM), f32) * NSA_HEAD_DIM ** -0.5,
        "rel_bias": 0.5 * nrm(ks[13], (REL_BUCKETS, NSA_HEADS), f32),
        "w_out": nrm(ks[14], (D_MIX, D_MODEL), f32) * D_MIX ** -0.5,
        "final_norm_gain": 1.0 + 0.02 * nrm(ks[15], (D_MODEL,), f32),
    }


def reference(x, norm_gain, w_in, w_conv, b_igate, b_fgate, mlstm_norm_gain,
              cmp_k_pos, cmp_k_w1, cmp_k_w2, cmp_v_pos, cmp_v_w1, cmp_v_w2,
              rel_bias, w_out, final_norm_gain):
    b_, t_, _ = x.shape
    f32 = jnp.float32
    split_points = [int(s) for s in np.cumsum(SPLIT_SIZES)[:-1]]
    for _layer in range(DEPTH):
        h = _rmsnorm(x, norm_gain)
        proj = h @ w_in
        (m_q, m_k, m_v, m_o, m_z, m_i, m_f, a_q, ck, cv, sk, sv, wk, wv, a_gate, a_z) = \
            jnp.split(proj, split_points, axis=-1)

        qk = jax.nn.silu(_causal_conv(jnp.concatenate([m_q, m_k], axis=-1), w_conv))
        mq, mk = jnp.split(qk.astype(f32), 2, axis=-1)
        mq = mq.reshape(b_, t_, MLSTM_HEADS, MLSTM_QK_DIM)
        mk = mk.reshape(b_, t_, MLSTM_HEADS, MLSTM_QK_DIM)
        mv = m_v.astype(f32).reshape(b_, t_, MLSTM_HEADS, MLSTM_V_DIM)
        i_pre = m_i.astype(f32) + b_igate.astype(f32)
        f_pre = m_f.astype(f32) + b_fgate.astype(f32)
        h_m = _mlstm(mq, mk, mv, i_pre, f_pre)
        h_m = jax.nn.sigmoid(m_o.astype(f32)).reshape(b_, t_, MLSTM_HEADS, MLSTM_V_DIM) * h_m
        h_m = h_m * lax.rsqrt(jnp.mean(h_m * h_m, axis=-1, keepdims=True) + RMS_EPS)
        h_m = h_m * mlstm_norm_gain.astype(f32).reshape(MLSTM_HEADS, MLSTM_V_DIM)
        y_m = h_m.reshape(b_, t_, MLSTM_WIDTH) * jax.nn.silu(m_z.astype(f32))

        o_a = _nsa(a_q, ck, cv, sk, sv, wk, wv, a_gate,
                   cmp_k_pos, cmp_k_w1, cmp_k_w2, cmp_v_pos, cmp_v_w1, cmp_v_w2, rel_bias)
        y_a = o_a.astype(f32) * jax.nn.silu(a_z.astype(f32))

        mix = jnp.concatenate([y_m, y_a], axis=-1).astype(x.dtype)
        x = x + mix @ w_out
    return _rmsnorm(x, final_norm_gain)
```

```cpp
#include <hip/hip_runtime.h>
#include <hip/hip_cooperative_groups.h>
#include <cstdio>
namespace cg = cooperative_groups;

#ifndef N_LAUNCH_SPLIT
#define N_LAUNCH_SPLIT 0
#endif

#define LAS __attribute__((address_space(3)))
typedef unsigned short bf16_t;
typedef short bf16x8 __attribute__((ext_vector_type(8)));
typedef short bf16x4 __attribute__((ext_vector_type(4)));
typedef float f32x4 __attribute__((ext_vector_type(4)));
typedef unsigned u32x4 __attribute__((ext_vector_type(4)));
typedef unsigned u32x2 __attribute__((ext_vector_type(2)));

constexpr int NB = 4, T = 4096, D = 4096, MROWS = NB * T;
constexpr int NP = 15360;
constexpr int NWIN = 15424;
constexpr int W_IN_COLS = 15416;
constexpr int C_MQ = 0, C_MK = 1024, C_MV = 2048, C_MO = 4096, C_MZ = 6144, C_AQ = 8192, C_CK = 10240, C_CV = 10752,
              C_SK = 11264, C_SV = 11776, C_WK = 12288, C_WV = 12800, C_AZ = 13312;
constexpr int NTHREADS = 512;
constexpr int LDS_BYTES = 147456;

constexpr size_t WS_HB = 0;
constexpr size_t WS_WIN = WS_HB + (size_t)MROWS * D * 2;
constexpr size_t WS_WOUT = WS_WIN + (size_t)NWIN * D * 2;
constexpr size_t WS_PROJ = WS_WOUT + (size_t)D * D * 2;
constexpr size_t WS_GATES = WS_PROJ + (size_t)MROWS * NP * 2;
constexpr size_t WS_QKC = WS_GATES + (size_t)MROWS * 64 * 4;
constexpr size_t WS_SVT = WS_QKC + (size_t)MROWS * 2048 * 2;
constexpr size_t WS_WVT = WS_SVT + (size_t)16 * 128 * 4096 * 2;
constexpr size_t WS_KC = WS_WVT + (size_t)16 * 128 * 4096 * 2;
constexpr size_t WS_VCT = WS_KC + (size_t)16 * 256 * 128 * 2;
constexpr size_t WS_W1T = WS_VCT + (size_t)16 * 256 * 128 * 2;
constexpr size_t WS_W2T = WS_W1T + (size_t)2 * 128 * 4096 * 2;
constexpr size_t WS_PB = WS_W2T + (size_t)2 * 128 * 128 * 2;
constexpr size_t WS_HM = WS_PB + 1024;
constexpr size_t WS_SS = WS_HM + (size_t)MROWS * 2048 * 2;
constexpr size_t WS_SSQ = WS_SS + (size_t)MROWS * 128 * 4;
constexpr size_t WS_END = WS_SSQ + (size_t)MROWS * 64 * 4;

struct Args { const float* in[16]; float* out; unsigned char* ws; int ph_lo, ph_hi; };

__device__ __forceinline__ unsigned pk_bf16(float lo, float hi) { unsigned r; asm("v_cvt_pk_bf16_f32 %0, %1, %2" : "=v"(r) : "v"(lo), "v"(hi)); return r; }
__device__ __forceinline__ bf16_t f2bf(float f) { return (bf16_t)(pk_bf16(f, 0.f) & 0xffffu); }
__device__ __forceinline__ float bf2f(unsigned b) { return __uint_as_float(b << 16); }
__device__ __forceinline__ float bflo(unsigned w) { return __uint_as_float(w << 16); }
__device__ __forceinline__ float bfhi(unsigned w) { return __uint_as_float(w & 0xffff0000u); }
__device__ __forceinline__ float wave_sum(float v) {
#pragma unroll
    for (int o = 32; o >= 1; o >>= 1) v += __shfl_xor(v, o);
    return v;
}
__device__ __forceinline__ float siluf(float x) { return x / (1.f + __expf(-x)); }
__device__ __forceinline__ float sigm(float x) { return 1.f / (1.f + __expf(-x)); }
__device__ __forceinline__ f32x4 mfma16(bf16x8 a, bf16x8 b, f32x4 c) { return __builtin_amdgcn_mfma_f32_16x16x32_bf16(a, b, c, 0, 0, 0); }
__device__ __forceinline__ bf16x8 as_bf16x8(u32x4 v) { union { u32x4 u; bf16x8 b; } x; x.u = v; return x.b; }

namespace pg8 {
constexpr int BM = 256, BK = 64, HALF = 128, HTB = HALF * BK * 2, STAGE_BYTES = 8 * HTB, NXCD = 8, WGM = 8;
__host__ __device__ __forceinline__ int lds_byte(int r, int c) { const int st = (r >> 4) * 2 + (c >> 5), rr = r & 15, cc = c & 31, ob = rr * 64 + cc * 2; return st * 1024 + (ob ^ (((ob >> 9) & 1) << 5)); }
__host__ __device__ __forceinline__ void stage_rc(int b, int& R, int& C) { const int st = b / 1024, sb = b % 1024, swz = sb ^ (((sb >> 9) & 1) << 5); R = (st >> 1) * 16 + swz / 64; C = (st & 1) * 32 + (swz % 64) / 2; }
__host__ __device__ __forceinline__ int perm32(int rho) { const int n = rho >> 4, i = rho & 15; return 8 * (i >> 2) + 4 * n + (i & 3); }
struct Unit { int pm, pn; };
struct Gemm { const bf16_t* A; const bf16_t* Bt; int M, N, K; };
struct StaticOrder {
    int nM, nN, nwg, G, c;
    __device__ void init(int M, int N, int G_, int c_) { nM = M / BM; nN = N / BM; nwg = nM * nN; G = G_; c = c_; }
    __device__ bool next(int i, Unit& u) const {
        const long L = (long)i * G + c; if (L >= nwg) return false;
        int wgid = (int)L; { const int q = nwg / NXCD, r = nwg % NXCD, xcd = wgid % NXCD, off = wgid / NXCD; wgid = (xcd < r ? xcd * (q + 1) : r * (q + 1) + (xcd - r) * q) + off; }
        const int nig = WGM * nN, gid = wgid / nig, fm = gid * WGM, gsz = (nM - fm) < WGM ? (nM - fm) : WGM;
        u.pm = fm + ((wgid % nig) % gsz); u.pn = (wgid % nig) / gsz; return true;
    }
};

template <class Epi>
__device__ __forceinline__ void gemm_phase(LAS unsigned char* lds, const Gemm g, const StaticOrder& S, const Epi& E) {
    const int tid = threadIdx.x, wid = __builtin_amdgcn_readfirstlane(tid >> 6), lane = tid & 63, wr = wid >> 2, wc = wid & 3, fr = lane & 15, fq = lane >> 4;
    const int K = g.K, nt = K / BK;
    unsigned voffA[2], voffB[2];
#pragma unroll
    for (int i = 0; i < 2; ++i) { int R, C; stage_rc(tid * 16 + i * 8192, R, C); const int Rb = Epi::PERM ? ((R & ~31) + perm32(R & 31)) : R;
        voffA[i] = (unsigned)(R * K + C) * 2u; voffB[i] = (unsigned)(Rb * K + C) * 2u; }
    const size_t kstep = (size_t)(BK * 2);
    const size_t hstep = (size_t)HALF * K * 2;
    const size_t tstep = 2 * hstep;
    const unsigned ldsw = (unsigned)wid * 1024u;
    const int aoff = lds_byte(wr * 64 + fr, fq * 8), boff = lds_byte(wc * 32 + fr, fq * 8);
#define PG8_SA(b, h) (((b) * 2 + (h)) * HTB)
#define PG8_SB(b, h) ((4 + (b) * 2 + (h)) * HTB)
#define PG8_STAGE(bufoff, gbase, voff) do { _Pragma("unroll") for (int _i = 0; _i < 2; ++_i) \
        __builtin_amdgcn_global_load_lds((const unsigned*)((const char*)(gbase) + (voff)[_i]), (LAS unsigned*)(lds + (bufoff) + ldsw + _i * 8192), 16, 0, 0); } while (0)
#define PG8_LDA(dst, b, h) do { _Pragma("unroll") for (int m = 0; m < 4; ++m) _Pragma("unroll") for (int k = 0; k < 2; ++k) dst[m][k] = *(const LAS bf16x8*)(lds + PG8_SA(b, h) + aoff + m * 2048 + k * 1024); } while (0)
#define PG8_LDB(dst, b, h) do { _Pragma("unroll") for (int n = 0; n < 2; ++n) _Pragma("unroll") for (int k = 0; k < 2; ++k) dst[n][k] = *(const LAS bf16x8*)(lds + PG8_SB(b, h) + boff + n * 2048 + k * 1024); } while (0)
#define PG8_MMA(ai, bj, At, Bt) do { __builtin_amdgcn_s_setprio(1); _Pragma("unroll") for (int m = 0; m < 4; ++m) _Pragma("unroll") for (int n = 0; n < 2; ++n) _Pragma("unroll") for (int k = 0; k < 2; ++k) \
        acc[ai][bj][m][n] = __builtin_amdgcn_mfma_f32_16x16x32_bf16(Bt[n][k], At[m][k], acc[ai][bj][m][n], 0, 0, 0); __builtin_amdgcn_s_setprio(0); } while (0)
#define PG8_WAIT_V(n) asm volatile("s_waitcnt vmcnt(" #n ")" ::: "memory")
#define PG8_WAIT_L(n) asm volatile("s_waitcnt lgkmcnt(" #n ")" ::: "memory")
#define PG8_BAR __builtin_amdgcn_s_barrier()
#define PG8_SCHED __builtin_amdgcn_sched_barrier(0)
    Unit cur, nxt; int ui = 0;
    if (!S.next(0, cur)) return;
    f32x4 acc[2][2][4][2];
#pragma unroll
    for (int a = 0; a < 2; ++a)
#pragma unroll
        for (int b = 0; b < 2; ++b)
#pragma unroll
            for (int m = 0; m < 4; ++m)
#pragma unroll
                for (int n = 0; n < 2; ++n) acc[a][b][m][n] = (f32x4){0.f, 0.f, 0.f, 0.f};
    bf16x8 At[4][2], B0[2][2], B1[2][2];
    const char* cA = (const char*)g.A + (size_t)cur.pm * tstep; const char* cB = (const char*)g.Bt + (size_t)cur.pn * tstep;
    PG8_STAGE(PG8_SB(0, 0), cB, voffB); PG8_STAGE(PG8_SA(0, 0), cA, voffA); PG8_STAGE(PG8_SB(0, 1), cB + hstep, voffB); PG8_STAGE(PG8_SA(0, 1), cA + hstep, voffA);
    if (wr == 1) PG8_BAR;
    PG8_WAIT_V(4); PG8_BAR;
    PG8_STAGE(PG8_SB(1, 0), cB + kstep, voffB); PG8_STAGE(PG8_SA(1, 0), cA + kstep, voffA); PG8_STAGE(PG8_SB(1, 1), cB + hstep + kstep, voffB);
    PG8_WAIT_V(6); PG8_BAR;
    for (;;) {
        const bool has_next = S.next(ui + 1, nxt);
        const char* nA = has_next ? (const char*)g.A + (size_t)nxt.pm * tstep : cA; const char* nB = has_next ? (const char*)g.Bt + (size_t)nxt.pn * tstep : cB;
        for (int t = 0; t < nt; t += 2) {
            const bool last = (t == nt - 2);
            const char* a1 = cA + (size_t)(t + 1) * kstep;
            const char* a2 = last ? nA : cA + (size_t)(t + 2) * kstep; const char* b2 = last ? nB : cB + (size_t)(t + 2) * kstep;
            const char* a3 = a2 + kstep; const char* b3 = b2 + kstep;
            PG8_LDB(B0, 0, 0); PG8_SCHED; PG8_LDA(At, 0, 0); PG8_STAGE(PG8_SA(1, 1), a1 + hstep, voffA);
            PG8_WAIT_L(8); PG8_BAR; PG8_WAIT_L(0); PG8_MMA(0, 0, At, B0); PG8_BAR; PG8_SCHED;
            PG8_LDB(B1, 0, 1); PG8_STAGE(PG8_SB(0, 0), b2, voffB);
            PG8_BAR; PG8_WAIT_L(0); PG8_MMA(0, 1, At, B1); PG8_BAR;
            PG8_LDA(At, 0, 1); PG8_STAGE(PG8_SA(0, 0), a2, voffA);
            PG8_BAR; PG8_WAIT_L(0); PG8_MMA(1, 0, At, B0); PG8_BAR; PG8_SCHED;
            PG8_STAGE(PG8_SB(0, 1), b2 + hstep, voffB);
            PG8_WAIT_V(6); PG8_BAR; PG8_MMA(1, 1, At, B1); PG8_BAR;
            PG8_LDB(B0, 1, 0); PG8_SCHED; PG8_LDA(At, 1, 0); PG8_STAGE(PG8_SA(0, 1), a2 + hstep, voffA);
            PG8_WAIT_L(8); PG8_BAR; PG8_WAIT_L(0); PG8_MMA(0, 0, At, B0); PG8_BAR; PG8_SCHED;
            PG8_LDB(B1, 1, 1); PG8_STAGE(PG8_SB(1, 0), b3, voffB);
            PG8_BAR; PG8_WAIT_L(0); PG8_MMA(0, 1, At, B1); PG8_BAR;
            PG8_LDA(At, 1, 1); PG8_STAGE(PG8_SA(1, 0), a3, voffA);
            PG8_BAR; PG8_WAIT_L(0); PG8_MMA(1, 0, At, B0); PG8_BAR; PG8_SCHED;
            PG8_STAGE(PG8_SB(1, 1), b3 + hstep, voffB);
            PG8_WAIT_V(6); PG8_BAR; PG8_MMA(1, 1, At, B1); PG8_BAR;
        }
        E(acc, cur, wr, wc, fr, fq);
        if (!has_next) break;
#pragma unroll
        for (int a = 0; a < 2; ++a)
#pragma unroll
            for (int b = 0; b < 2; ++b)
#pragma unroll
                for (int m = 0; m < 4; ++m)
#pragma unroll
                    for (int n = 0; n < 2; ++n) acc[a][b][m][n] = (f32x4){0.f, 0.f, 0.f, 0.f};
        cur = nxt; cA = nA; cB = nB; ++ui;
    }
    PG8_WAIT_V(0);
    if (wr == 0) PG8_BAR;
    PG8_BAR;
#undef PG8_SA
#undef PG8_SB
#undef PG8_STAGE
#undef PG8_LDA
#undef PG8_LDB
#undef PG8_MMA
#undef PG8_WAIT_V
#undef PG8_WAIT_L
#undef PG8_BAR
#undef PG8_SCHED
}

struct EpiProj {
    static constexpr bool PERM = true;
    bf16_t* O; int ldc;
    __device__ __forceinline__ void operator()(const f32x4 (&acc)[2][2][4][2], const Unit& u, int wr, int wc, int fr, int fq) const {
        const int row0 = u.pm * BM + wr * 64 + fr, col0 = u.pn * BM + wc * 32 + 8 * fq;
#pragma unroll
        for (int ai = 0; ai < 2; ++ai)
#pragma unroll
            for (int m = 0; m < 4; ++m) { bf16_t* rowp = O + (size_t)(row0 + ai * HALF + m * 16) * ldc + col0;
#pragma unroll
                for (int bj = 0; bj < 2; ++bj) { const f32x4 v0 = acc[ai][bj][m][0], v1 = acc[ai][bj][m][1];
                    u32x4 w; w.x = pk_bf16(v0[0], v0[1]); w.y = pk_bf16(v0[2], v0[3]); w.z = pk_bf16(v1[0], v1[1]); w.w = pk_bf16(v1[2], v1[3]);
                    *(u32x4*)(rowp + bj * HALF) = w; } }
    }
};
struct EpiOut {
    static constexpr bool PERM = false;
    const float* x; float* out; float* ssq;
    __device__ __forceinline__ void operator()(const f32x4 (&acc)[2][2][4][2], const Unit& u, int wr, int wc, int fr, int fq) const {
        const int row0 = u.pm * BM + wr * 64 + fr, col0 = u.pn * BM + wc * 32 + 4 * fq;
#pragma unroll
        for (int ai = 0; ai < 2; ++ai)
#pragma unroll
            for (int m = 0; m < 4; ++m) { const int row = row0 + ai * HALF + m * 16; const size_t off = (size_t)row * D + col0; float s = 0.f;
#pragma unroll
                for (int bj = 0; bj < 2; ++bj)
#pragma unroll
                    for (int n = 0; n < 2; ++n) { const f32x4 xv = *(const f32x4*)(x + off + bj * HALF + n * 16); const f32x4 v = acc[ai][bj][m][n] + xv;
                        *(f32x4*)(out + off + bj * HALF + n * 16) = v; s += (v[0] * v[0] + v[1] * v[1]) + (v[2] * v[2] + v[3] * v[3]); }
                s += __shfl_xor(s, 16); s += __shfl_xor(s, 32);
                if (fq == 0) ssq[(size_t)row * 64 + u.pn * 4 + wc] = s; }
    }
};
}

__device__ __forceinline__ int map_win(int n) {
    if (n < 8192) return n;
    if (n < 13312) return n + 8;
    if (n < 15360) return n + 56;
    if (n < 15368) return n - 15360 + 8192;
    if (n < 15416) return n - 15368 + 13320;
    return -1;
}
template <bool WIN>
__device__ void transpose_cvt(const float* __restrict__ src, int src_ld, bf16_t* __restrict__ dst, int K, int ntn, LAS float* tile) {
    const int tid = threadIdx.x, nkt = K / 64, total = ntn * nkt;
    for (int idx = blockIdx.x; idx < total; idx += gridDim.x) {
        const int tn = idx / nkt, tk = idx - tn * nkt;
#pragma unroll
        for (int i = 0; i < 2; ++i) {
            const int kk = (tid >> 4) + 32 * i, n4 = (tid & 15) * 4, n = tn * 64 + n4;
            const int sc = WIN ? map_win(n) : n;
            f32x4 v = (f32x4){0.f, 0.f, 0.f, 0.f};
            if (sc >= 0) v = *(const f32x4*)(src + (size_t)(tk * 64 + kk) * src_ld + sc);
            tile[kk * 65 + n4 + 0] = v[0]; tile[kk * 65 + n4 + 1] = v[1]; tile[kk * 65 + n4 + 2] = v[2]; tile[kk * 65 + n4 + 3] = v[3];
        }
        __syncthreads();
        {
            const int n = tid >> 3, k8 = (tid & 7) * 8;
            float e[8];
#pragma unroll
            for (int j = 0; j < 8; ++j) e[j] = tile[(k8 + j) * 65 + n];
            u32x4 w; w.x = pk_bf16(e[0], e[1]); w.y = pk_bf16(e[2], e[3]); w.z = pk_bf16(e[4], e[5]); w.w = pk_bf16(e[6], e[7]);
            *(u32x4*)(dst + (size_t)(tn * 64 + n) * K + tk * 64 + k8) = w;
        }
        __syncthreads();
    }
}

__device__ void phase0(const Args& a, LAS unsigned char* lds) {
    const int tid = threadIdx.x, lane = tid & 63;
    unsigned char* ws = a.ws;
    LAS float* tile = (LAS float*)lds;
    if (blockIdx.x < 2) {
        const float* pos = blockIdx.x ? a.in[10] : a.in[7]; const float* w1 = blockIdx.x ? a.in[11] : a.in[8];
        const int e = tid & 127, part = tid >> 7; float s = 0.f;
        for (int k = part * 1024; k < part * 1024 + 1024; ++k) s += pos[k] * w1[(size_t)k * 128 + e];
        tile[tid] = s; __syncthreads();
        if (tid < 128) ((float*)(ws + WS_PB))[blockIdx.x * 128 + tid] = (tile[tid] + tile[tid + 128]) + (tile[tid + 256] + tile[tid + 384]);
        __syncthreads();
    }
    {
        const float* x = a.in[0]; const float* gain = a.in[1]; bf16_t* HB = (bf16_t*)(ws + WS_HB);
        const int gw = blockIdx.x * 8 + (tid >> 6), nw = gridDim.x * 8;
        for (int row = gw; row < MROWS; row += nw) {
            const f32x4* xr = (const f32x4*)(x + (size_t)row * D);
            f32x4 v[16]; float ss = 0.f;
#pragma unroll
            for (int i = 0; i < 16; ++i) { v[i] = xr[lane + 64 * i]; ss += (v[i][0] * v[i][0] + v[i][1] * v[i][1]) + (v[i][2] * v[i][2] + v[i][3] * v[i][3]); }
            ss = wave_sum(ss);
            const float rstd = 1.0f / sqrtf(ss * (1.0f / D) + 1e-6f);
#pragma unroll
            for (int i = 0; i < 16; ++i) { const f32x4 g = ((const f32x4*)gain)[lane + 64 * i];
                u32x2 w; w.x = pk_bf16(v[i][0] * rstd * g[0], v[i][1] * rstd * g[1]); w.y = pk_bf16(v[i][2] * rstd * g[2], v[i][3] * rstd * g[3]);
                *(u32x2*)(HB + (size_t)row * D + (lane + 64 * i) * 4) = w; }
        }
    }
    transpose_cvt<true>(a.in[2], W_IN_COLS, (bf16_t*)(ws + WS_WIN), D, NWIN / 64, tile);
    transpose_cvt<false>(a.in[14], D, (bf16_t*)(ws + WS_WOUT), D, D / 64, tile);
    transpose_cvt<false>(a.in[8], 128, (bf16_t*)(ws + WS_W1T), 4096, 2, tile);
    transpose_cvt<false>(a.in[11], 128, (bf16_t*)(ws + WS_W1T) + 128 * 4096, 4096, 2, tile);
    transpose_cvt<false>(a.in[9], 128, (bf16_t*)(ws + WS_W2T), 128, 2, tile);
    transpose_cvt<false>(a.in[12], 128, (bf16_t*)(ws + WS_W2T) + 128 * 128, 128, 2, tile);
}

__device__ void gate_gemm(const Args& a) {
    const int tid = threadIdx.x, lane = tid & 63, l16 = lane & 15, g4 = lane >> 4;
    const bf16_t* HB = (const bf16_t*)(a.ws + WS_HB); const bf16_t* WG = (const bf16_t*)(a.ws + WS_WIN) + (size_t)NP * D;
    float* GATES = (float*)(a.ws + WS_GATES);
    const int gw = blockIdx.x * 8 + (tid >> 6), nw = gridDim.x * 8;
    for (int item = gw; item < 2048; item += nw) {
        const int rg = item >> 1, nh = item & 1;
        const bf16_t* Ap = HB + (size_t)(rg * 16 + l16) * D + g4 * 8;
        const bf16_t* B0 = WG + (size_t)(nh * 32 + l16) * D + g4 * 8;
        const bf16_t* B1 = B0 + (size_t)16 * D;
        f32x4 c0 = (f32x4){0.f, 0.f, 0.f, 0.f}, c1 = c0;
#pragma unroll 8
        for (int ks = 0; ks < 128; ++ks) {
            const bf16x8 av = *(const bf16x8*)(Ap + ks * 32), b0 = *(const bf16x8*)(B0 + ks * 32), b1 = *(const bf16x8*)(B1 + ks * 32);
            c0 = mfma16(av, b0, c0); c1 = mfma16(av, b1, c1);
        }
#pragma unroll
        for (int r = 0; r < 4; ++r) { float* gp = GATES + (size_t)(rg * 16 + g4 * 4 + r) * 64 + nh * 32 + l16; gp[0] = c0[r]; gp[16] = c1[r]; }
    }
}

__device__ void phase2(const Args& a, LAS unsigned char* lds) {
    const int tid = threadIdx.x, lane = tid & 63, wv = tid >> 6, l16 = lane & 15, g4 = lane >> 4;
    unsigned char* ws = a.ws;
    const bf16_t* PROJ = (const bf16_t*)(ws + WS_PROJ);
    {
        const float* wconv = a.in[3]; bf16_t* QKC = (bf16_t*)(ws + WS_QKC);
        for (int it = blockIdx.x * NTHREADS + tid; it < 65536; it += gridDim.x * NTHREADS) {
            const int c8 = it & 255, run = it >> 8, row0 = run * 64, tfirst = row0 & (T - 1);
            float w[4][8];
#pragma unroll
            for (int j = 0; j < 4; ++j) { const f32x4 wa = *(const f32x4*)(wconv + j * 2048 + c8 * 8), wb = *(const f32x4*)(wconv + j * 2048 + c8 * 8 + 4);
                w[j][0] = wa[0]; w[j][1] = wa[1]; w[j][2] = wa[2]; w[j][3] = wa[3]; w[j][4] = wb[0]; w[j][5] = wb[1]; w[j][6] = wb[2]; w[j][7] = wb[3]; }
            const float osc = (c8 >= 128) ? 0.0625f : 1.0f;
            u32x4 u0 = (u32x4){0, 0, 0, 0}, u1 = u0, u2 = u0;
            const bf16_t* src = PROJ + (size_t)row0 * NP + c8 * 8;
            if (tfirst != 0) { u0 = *(const u32x4*)(src - 3 * (size_t)NP); u1 = *(const u32x4*)(src - 2 * (size_t)NP); u2 = *(const u32x4*)(src - (size_t)NP); }
            for (int l = 0; l < 64; ++l) {
                const u32x4 u3 = *(const u32x4*)(src + (size_t)l * NP);
                float y[8];
#pragma unroll
                for (int e = 0; e < 4; ++e) {
                    y[2 * e] = w[0][2 * e] * bflo(u0[e]) + w[1][2 * e] * bflo(u1[e]) + w[2][2 * e] * bflo(u2[e]) + w[3][2 * e] * bflo(u3[e]);
                    y[2 * e + 1] = w[0][2 * e + 1] * bfhi(u0[e]) + w[1][2 * e + 1] * bfhi(u1[e]) + w[2][2 * e + 1] * bfhi(u2[e]) + w[3][2 * e + 1] * bfhi(u3[e]);
                }
#pragma unroll
                for (int e = 0; e < 8; ++e) y[e] = siluf(y[e]) * osc;
                u32x4 o; o.x = pk_bf16(y[0], y[1]); o.y = pk_bf16(y[2], y[3]); o.z = pk_bf16(y[4], y[5]); o.w = pk_bf16(y[6], y[7]);
                *(u32x4*)(QKC + (size_t)(row0 + l) * 2048 + c8 * 8) = o;
                u0 = u1; u1 = u2; u2 = u3;
            }
        }
    }
    {
        LAS bf16_t* tl = (LAS bf16_t*)lds;
        for (int idx = blockIdx.x; idx < 2048; idx += gridDim.x) {
            const int which = idx >> 10, bg = (idx >> 6) & 15, tt = idx & 63, b = bg >> 2, g = bg & 3;
            const bf16_t* src = PROJ + (size_t)(b * T + tt * 64) * NP + (which ? C_WV : C_SV) + g * 128;
            bf16_t* dst = (bf16_t*)(ws + (which ? WS_WVT : WS_SVT)) + (size_t)bg * 128 * T + tt * 64;
#pragma unroll
            for (int i = 0; i < 2; ++i) { const int p = tid + 512 * i, t = p >> 4, d8 = (p & 15) * 8;
                *(LAS u32x4*)(tl + t * 136 + d8) = *(const u32x4*)(src + (size_t)t * NP + d8); }
            __syncthreads();
            { const int d = tid >> 2, t16 = (tid & 3) * 16; unsigned e[16];
#pragma unroll
              for (int j = 0; j < 16; ++j) e[j] = tl[(t16 + j) * 136 + d];
              u32x4 w0, w1; w0.x = e[0] | (e[1] << 16); w0.y = e[2] | (e[3] << 16); w0.z = e[4] | (e[5] << 16); w0.w = e[6] | (e[7] << 16);
              w1.x = e[8] | (e[9] << 16); w1.y = e[10] | (e[11] << 16); w1.z = e[12] | (e[13] << 16); w1.w = e[14] | (e[15] << 16);
              *(u32x4*)(dst + (size_t)d * T + t16) = w0; *(u32x4*)(dst + (size_t)d * T + t16 + 8) = w1; }
            __syncthreads();
        }
    }
    {
        LAS bf16_t* hid = (LAS bf16_t*)lds;
        const float* PB = (const float*)(ws + WS_PB);
        bf16_t* KC = (bf16_t*)(ws + WS_KC); bf16_t* VCT = (bf16_t*)(ws + WS_VCT);
        for (int item = blockIdx.x; item < 512; item += gridDim.x) {
            const int kv = item >> 8, bg = (item >> 4) & 15, ng = item & 15, b = bg >> 2, g = bg & 3;
            const bf16_t* W1 = (const bf16_t*)(ws + WS_W1T) + (size_t)kv * 128 * 4096; const bf16_t* W2 = (const bf16_t*)(ws + WS_W2T) + kv * 128 * 128;
            int n = ng * 16 + l16; if (n > 254) n = 254;
            const bf16_t* Ap = PROJ + (size_t)(b * T + 16 * n) * NP + (kv ? C_CV : C_CK) + g * 128 + g4 * 8;
            const bf16_t* Bp = W1 + (size_t)(16 * wv + l16) * 4096 + g4 * 8;
            f32x4 acc = (f32x4){0.f, 0.f, 0.f, 0.f};
#pragma unroll 2
            for (int l = 0; l < 32; ++l)
#pragma unroll
                for (int dq = 0; dq < 4; ++dq) acc = mfma16(*(const bf16x8*)(Ap + (size_t)l * NP + dq * 32), *(const bf16x8*)(Bp + l * 128 + dq * 32), acc);
            const float pbe = PB[kv * 128 + 16 * wv + l16];
#pragma unroll
            for (int r = 0; r < 4; ++r) hid[(4 * g4 + r) * 136 + 16 * wv + l16] = f2bf(siluf(acc[r] + pbe));
            __syncthreads();
            f32x4 acc2 = (f32x4){0.f, 0.f, 0.f, 0.f};
#pragma unroll
            for (int ks = 0; ks < 4; ++ks) acc2 = mfma16(*(const LAS bf16x8*)(hid + l16 * 136 + ks * 32 + g4 * 8), *(const bf16x8*)(W2 + (16 * wv + l16) * 128 + ks * 32 + g4 * 8), acc2);
            const int f = 16 * wv + l16, nb = ng * 16 + 4 * g4;
            float o[4];
#pragma unroll
            for (int r = 0; r < 4; ++r) o[r] = (nb + r < 255) ? acc2[r] : 0.f;
            if (kv == 0) {
#pragma unroll
                for (int r = 0; r < 4; ++r) KC[((size_t)bg * 256 + nb + r) * 128 + f] = f2bf(o[r]);
            } else { u32x2 w; w.x = pk_bf16(o[0], o[1]); w.y = pk_bf16(o[2], o[3]); *(u32x2*)(VCT + ((size_t)bg * 128 + f) * 256 + nb) = w; }
            __syncthreads();
        }
    }
}

__device__ __forceinline__ void mlstm_item(const Args& a, LAS unsigned char* lds, int item) {
    const int tid = threadIdx.x, lane = tid & 63, w = __builtin_amdgcn_readfirstlane(tid >> 6), l16 = lane & 15, g4 = lane >> 4;
    const int bh = item >> 4, sl = item & 15, b = bh >> 2, h = bh & 3;
    unsigned char* ws = a.ws;
    const bf16_t* PROJ = (const bf16_t*)(ws + WS_PROJ); const bf16_t* QKC = (const bf16_t*)(ws + WS_QKC); const float* GATES = (const float*)(ws + WS_GATES);
    bf16_t* HM = (bf16_t*)(ws + WS_HM); float* SS = (float*)(ws + WS_SS);
    LAS bf16_t* qs = (LAS bf16_t*)lds;
    LAS bf16_t* ks = qs + 64 * 264;
    LAS bf16_t* kT = ks + 64 * 264;
    LAS bf16_t* vT = kT + 256 * 72;
    LAS bf16_t* vTw = vT + 48 * 72;
    LAS bf16_t* CT = vTw + 48 * 72;
    LAS float* sc = (LAS float*)(CT + 48 * 264);
    LAS bf16_t* Pm = ks;
    for (int i = tid; i < 48 * 264; i += NTHREADS) CT[i] = 0;
    for (int i = tid; i < 16 * 72; i += NTHREADS) { const int r = i / 72; vT[(32 + r) * 72 + (i - r * 72)] = (r == 0) ? (bf16_t)0x3F80 : (bf16_t)0; vTw[(32 + r) * 72 + (i - r * 72)] = 0; }
    f32x4 Cacc[2][3];
#pragma unroll
    for (int i = 0; i < 2; ++i)
#pragma unroll
        for (int j = 0; j < 3; ++j) Cacc[i][j] = (f32x4){0.f, 0.f, 0.f, 0.f};
    float m_st = 0.f;
    const float bi = a.in[4][h], bfg = a.in[5][h];
    u32x4 qreg[4], kreg[4], vreg; float gi = 0.f, gf = 0.f;
    vreg = (u32x4){0, 0, 0, 0};
    const size_t rowbase = (size_t)b * T;
#define ML_PREFETCH(t0_) do { \
        _Pragma("unroll") for (int i = 0; i < 4; ++i) { const int p = tid + 512 * i, l = p >> 5, c8 = (p & 31) * 8; const bf16_t* s_ = QKC + (rowbase + (t0_) + l) * 2048 + h * 256 + c8; \
            qreg[i] = *(const u32x4*)s_; kreg[i] = *(const u32x4*)(s_ + 1024); } \
        if (tid < 256) { const int l = tid >> 2, c8 = (tid & 3) * 8; vreg = *(const u32x4*)(PROJ + (rowbase + (t0_) + l) * NP + C_MV + h * 512 + sl * 32 + c8); } \
        if (tid < 64) { const float* gp = GATES + (rowbase + (t0_) + tid) * 64; gi = gp[h] + bi; gf = gp[4 + h] + bfg; } } while (0)
    ML_PREFETCH(0);
    __syncthreads();
    for (int c = 0; c < 64; ++c) {
        const int t0 = c * 64;
#pragma unroll
        for (int i = 0; i < 4; ++i) { const int p = tid + 512 * i, l = p >> 5, c8 = (p & 31) * 8;
            *(LAS u32x4*)(qs + l * 264 + c8) = qreg[i]; *(LAS u32x4*)(ks + l * 264 + c8) = kreg[i];
#pragma unroll
            for (int j = 0; j < 4; ++j) { kT[(c8 + 2 * j) * 72 + l] = (bf16_t)(kreg[i][j] & 0xffffu); kT[(c8 + 2 * j + 1) * 72 + l] = (bf16_t)(kreg[i][j] >> 16); } }
        if (tid < 256) { const int l = tid >> 2, c8 = (tid & 3) * 8;
#pragma unroll
            for (int j = 0; j < 4; ++j) { vT[(c8 + 2 * j) * 72 + l] = (bf16_t)(vreg[j] & 0xffffu); vT[(c8 + 2 * j + 1) * 72 + l] = (bf16_t)(vreg[j] >> 16); } }
        if (w == 0) {
            const float lf = fminf(gf, 0.f) - log1pf(__expf(-fabsf(gf)));
            float bc = lf;
#pragma unroll
            for (int o = 1; o < 64; o <<= 1) { const float t = __shfl_up(bc, o); if (lane >= o) bc += t; }
            const float av = gi - bc; float pm = av;
#pragma unroll
            for (int o = 1; o < 64; o <<= 1) { const float t = __shfl_up(pm, o); if (lane >= o) pm = fmaxf(pm, t); }
            const float gtot = __shfl(bc, 63);
            const float mrow = fmaxf(m_st, pm), mr63 = __shfl(mrow, 63);
            sc[lane] = av; sc[64 + lane] = mrow; sc[128 + lane] = __expf(m_st - mrow); sc[192 + lane] = __expf(-(bc + mrow)); sc[256 + lane] = __expf(av - mr63);
            if (lane == 0) sc[320] = __expf(m_st - mr63);
            m_st = gtot + mr63;
        }
        if (c + 1 < 64) ML_PREFETCH(t0 + 64);
        __syncthreads();
        const int mt = w & 3, nq = w >> 2;
        f32x4 s0 = (f32x4){0.f, 0.f, 0.f, 0.f}, s1 = s0, ci0 = s0, ci2 = s0;
        {
            const LAS bf16_t* ap = qs + (16 * mt + l16) * 264 + g4 * 8;
            const LAS bf16_t* b0p = ks + (16 * (2 * nq) + l16) * 264 + g4 * 8;
            const LAS bf16_t* b1p = b0p + 16 * 264;
            const LAS bf16_t* c0p = CT + (16 * nq + l16) * 264 + g4 * 8;
            const LAS bf16_t* c2p = CT + (32 + l16) * 264 + g4 * 8;
            const bool do0 = (2 * nq <= mt), do1 = (2 * nq + 1 <= mt);
#pragma unroll
            for (int kq = 0; kq < 8; ++kq) {
                const bf16x8 av = *(const LAS bf16x8*)(ap + kq * 32);
                if (do0) s0 = mfma16(av, *(const LAS bf16x8*)(b0p + kq * 32), s0);
                if (do1) s1 = mfma16(av, *(const LAS bf16x8*)(b1p + kq * 32), s1);
                ci0 = mfma16(av, *(const LAS bf16x8*)(c0p + kq * 32), ci0);
                ci2 = mfma16(av, *(const LAS bf16x8*)(c2p + kq * 32), ci2);
            }
        }
        __syncthreads();
        {
#pragma unroll
            for (int r = 0; r < 4; ++r) { const int l = 16 * mt + 4 * g4 + r; const float mr = sc[64 + l];
                { const int s = 16 * (2 * nq) + l16; const float pv = (s <= l) ? s0[r] * __expf(sc[s] - mr) : 0.f; Pm[l * 72 + s] = f2bf(pv); }
                { const int s = 16 * (2 * nq + 1) + l16; const float pv = (s <= l) ? s1[r] * __expf(sc[s] - mr) : 0.f; Pm[l * 72 + s] = f2bf(pv); } }
#pragma unroll
            for (int i = 0; i < 5; ++i) { const int idx = tid + 512 * i; if (idx < 33 * 64) { const int row = idx >> 6, s = idx & 63; const float wt = sc[256 + s];
                vTw[row * 72 + s] = f2bf(row < 32 ? bf2f(vT[row * 72 + s]) * wt : wt); } }
        }
        __syncthreads();
        {
            f32x4 n0 = (f32x4){0.f, 0.f, 0.f, 0.f}, n2 = n0;
#pragma unroll
            for (int kq = 0; kq < 2; ++kq) { const bf16x8 av = *(const LAS bf16x8*)(Pm + (16 * mt + l16) * 72 + kq * 32 + g4 * 8);
                n0 = mfma16(av, *(const LAS bf16x8*)(vT + (16 * nq + l16) * 72 + kq * 32 + g4 * 8), n0);
                n2 = mfma16(av, *(const LAS bf16x8*)(vT + (32 + l16) * 72 + kq * 32 + g4 * 8), n2); }
            const int col = h * 512 + sl * 32 + 16 * nq + l16;
#pragma unroll
            for (int r = 0; r < 4; ++r) { const int l = 16 * mt + 4 * g4 + r; const float il = sc[128 + l];
                const float num = n0[r] + il * ci0[r]; float qn = n2[r] + il * ci2[r]; qn = __shfl(qn, lane & 48);
                const float den = fmaxf(fabsf(qn), sc[192 + l]);
                const size_t row = rowbase + t0 + l;
                const float og = sigm(bf2f(PROJ[row * NP + C_MO + col]));
                const bf16_t hb = f2bf(og * num / den); HM[row * 2048 + col] = hb;
                float sq = bf2f(hb); sq *= sq;
                sq += __shfl_xor(sq, 1); sq += __shfl_xor(sq, 2); sq += __shfl_xor(sq, 4); sq += __shfl_xor(sq, 8);
                if (l16 == 0) SS[(row * 4 + h) * 32 + sl * 2 + nq] = sq; }
            const float keep = sc[320];
#pragma unroll
            for (int m2 = 0; m2 < 2; ++m2) {
#pragma unroll
                for (int j = 0; j < 3; ++j) Cacc[m2][j] *= keep;
#pragma unroll
                for (int kq = 0; kq < 2; ++kq) { const bf16x8 av = *(const LAS bf16x8*)(kT + (32 * w + 16 * m2 + l16) * 72 + kq * 32 + g4 * 8);
#pragma unroll
                    for (int j = 0; j < 3; ++j) Cacc[m2][j] = mfma16(av, *(const LAS bf16x8*)(vTw + (16 * j + l16) * 72 + kq * 32 + g4 * 8), Cacc[m2][j]); }
#pragma unroll
                for (int j = 0; j < 3; ++j) { u32x2 wv2; wv2.x = pk_bf16(Cacc[m2][j][0], Cacc[m2][j][1]); wv2.y = pk_bf16(Cacc[m2][j][2], Cacc[m2][j][3]);
                    *(LAS u32x2*)(CT + (16 * j + l16) * 264 + 32 * w + 16 * m2 + 4 * g4) = wv2; }
            }
        }
        __syncthreads();
    }
#undef ML_PREFETCH
}

struct TileDesc { const bf16_t* K; size_t kstr; const bf16_t* V; size_t vstr; int kp0, kstep, wlim, selj; };

constexpr float NEGL = -1e30f;
constexpr float QK_SC = 0.08838834764831845f * 1.4426950408889634f;

template <int MODE>
__device__ __forceinline__ void nsa_tile(const LAS bf16_t* Kt, const LAS bf16_t* Vt, const LAS float* TB, const TileDesc& td, const bf16x8 (&qf)[2][4],
                                         const int (&tq)[2], const unsigned long long (&selm)[2], int hh, int l16, int g4,
                                         f32x4 (&O)[8][2], float (&mrun)[2], float (&lrun)[2], const float (&invl)[2],
                                         LAS float* PA, LAS float* PBv, int w, int kt64, int t0) {
    const bool far = (t0 - (td.kp0 + 63 * td.kstep)) >= 790;
    const float bfar = TB[hh * 1024 + 1023];
#pragma unroll 1
    for (int i = 0; i < 2; ++i) {
        f32x4 S[2][2];
#pragma unroll
        for (int mm = 0; mm < 2; ++mm) { S[mm][0] = (f32x4){0.f, 0.f, 0.f, 0.f}; S[mm][1] = S[mm][0]; }
#pragma unroll
        for (int mm = 0; mm < 2; ++mm)
#pragma unroll
            for (int kq = 0; kq < 4; ++kq) { const bf16x8 av = *(const LAS bf16x8*)(Kt + (32 * i + 16 * mm + l16) * 136 + kq * 32 + g4 * 8);
                S[mm][0] = mfma16(av, qf[0][kq], S[mm][0]); S[mm][1] = mfma16(av, qf[1][kq], S[mm][1]); }
#pragma unroll
        for (int nt = 0; nt < 2; ++nt) {
            const bool allowed = (td.selj < 0) || ((selm[nt] >> td.selj) & 1ull);
            float mx = NEGL;
#pragma unroll
            for (int mm = 0; mm < 2; ++mm)
#pragma unroll
                for (int r = 0; r < 4; ++r) {
                    const int kk = 32 * i + 16 * mm + 4 * g4 + r, dist = tq[nt] - (td.kp0 + td.kstep * kk);
                    const bool ok = allowed && dist >= 0 && dist < td.wlim;
                    float bias = bfar;
                    if (!far) { int di = dist < 0 ? 0 : dist; di = di > 1023 ? 1023 : di; bias = TB[hh * 1024 + di]; }
                    const float lg = ok ? S[mm][nt][r] * QK_SC + bias : NEGL;
                    S[mm][nt][r] = lg; mx = fmaxf(mx, lg);
                }
            if (MODE != 1) {
                mx = fmaxf(mx, __shfl_xor(mx, 16)); mx = fmaxf(mx, __shfl_xor(mx, 32));
                const float mnew = fmaxf(mrun[nt], mx), alpha = exp2f(mrun[nt] - mnew);
                mrun[nt] = mnew; float ps = 0.f;
#pragma unroll
                for (int mm = 0; mm < 2; ++mm)
#pragma unroll
                    for (int r = 0; r < 4; ++r) { const float lg = S[mm][nt][r]; const float p = (lg <= -1e29f) ? 0.f : exp2f(lg - mnew); S[mm][nt][r] = p; ps += p; }
                lrun[nt] = lrun[nt] * alpha + ps;
                if (MODE == 2) {
#pragma unroll
                    for (int dt = 0; dt < 8; ++dt) O[dt][nt] *= alpha;
                }
            } else {
                const float mfix = mrun[nt], il = invl[nt];
#pragma unroll
                for (int mm = 0; mm < 2; ++mm) {
#pragma unroll
                    for (int r = 0; r < 4; ++r) { const float lg = S[mm][nt][r]; S[mm][nt][r] = (lg <= -1e29f) ? 0.f : exp2f(lg - mfix) * il; }
                    float pa = (S[mm][nt][0] + S[mm][nt][1]) + (S[mm][nt][2] + 0.5f * S[mm][nt][3]), pb = 0.5f * S[mm][nt][3];
                    pa += __shfl_xor(pa, 1); pa += __shfl_xor(pa, 2); pb += __shfl_xor(pb, 1); pb += __shfl_xor(pb, 2);
                    if ((l16 & 3) == 0) { const int tok = 8 * w + 4 * nt + (l16 >> 2), j = 16 * kt64 + 4 * (2 * i + mm) + g4; PA[tok * 65 + j] = pa; if (j + 1 < 64) PBv[tok * 65 + j + 1] = pb; }
                }
            }
        }
        if (MODE != 0) {
            bf16x8 pb[2];
#pragma unroll
            for (int nt = 0; nt < 2; ++nt) { u32x4 u; u.x = pk_bf16(S[0][nt][0], S[0][nt][1]); u.y = pk_bf16(S[0][nt][2], S[0][nt][3]);
                u.z = pk_bf16(S[1][nt][0], S[1][nt][1]); u.w = pk_bf16(S[1][nt][2], S[1][nt][3]); pb[nt] = as_bf16x8(u); }
#pragma unroll
            for (int dt = 0; dt < 8; ++dt) { const LAS bf16_t* vp = Vt + (16 * dt + l16) * 72 + 32 * i + 4 * g4;
                const u32x2 lo = *(const LAS u32x2*)vp, hi = *(const LAS u32x2*)(vp + 16);
                const bf16x8 av = as_bf16x8((u32x4){lo.x, lo.y, hi.x, hi.y});
                O[dt][0] = mfma16(av, pb[0], O[dt][0]); O[dt][1] = mfma16(av, pb[1], O[dt][1]); }
        }
    }
}

__device__ __forceinline__ void nsa_load(const TileDesc& td, int tid, u32x4 (&kr)[2], u32x4 (&vr)[2]) {
#pragma unroll
    for (int i = 0; i < 2; ++i) { const int p = tid + 512 * i;
        kr[i] = *(const u32x4*)(td.K + (size_t)(p >> 4) * td.kstr + (p & 15) * 8);
        vr[i] = *(const u32x4*)(td.V + (size_t)(p >> 3) * td.vstr + (p & 7) * 8); }
}
__device__ __forceinline__ void nsa_store(LAS bf16_t* Kb, LAS bf16_t* Vb, int tid, const u32x4 (&kr)[2], const u32x4 (&vr)[2]) {
#pragma unroll
    for (int i = 0; i < 2; ++i) { const int p = tid + 512 * i;
        *(LAS u32x4*)(Kb + (p >> 4) * 136 + (p & 15) * 8) = kr[i];
        *(LAS u32x4*)(Vb + (p >> 3) * 72 + (p & 7) * 8) = vr[i]; }
}

__device__ __forceinline__ void nsa_unit(const Args& a, LAS unsigned char* lds, int bg, int qb) {
    const int tid = threadIdx.x, lane = tid & 63, w = __builtin_amdgcn_readfirstlane(tid >> 6), l16 = lane & 15, g4 = lane >> 4;
    const int b = bg >> 2, g = bg & 3, t0 = qb * 64, hh = l16 & 3;
    unsigned char* ws = a.ws;
    const bf16_t* PROJ = (const bf16_t*)(ws + WS_PROJ); const float* GATES = (const float*)(ws + WS_GATES);
    LAS bf16_t* Kb0 = (LAS bf16_t*)lds;
    LAS bf16_t* Vb0 = Kb0 + 2 * 64 * 136;
    LAS float* TB = (LAS float*)(Vb0 + 2 * 128 * 72);
    LAS float* PA = TB + 4096;
    LAS float* PBv = PA + 64 * 65;
    LAS unsigned long long* SELM = (LAS unsigned long long*)(PBv + 64 * 65);
    LAS unsigned long long* UNI = SELM + 64;
    {
        const float* rel = a.in[13];
        for (int i = tid; i < 4096; i += NTHREADS) { const int h = i >> 10, d = i & 1023; int bk = d;
            if (d >= 16) { bk = 16 + (d >= 21) + (d >= 27) + (d >= 35) + (d >= 46) + (d >= 59) + (d >= 77) + (d >= 99) + (d >= 128) + (d >= 166) + (d >= 216) + (d >= 280) + (d >= 363) + (d >= 470) + (d >= 609) + (d >= 790); }
            TB[i] = rel[bk * 16 + g * 4 + h] * 1.4426950408889634f; }
        for (int i = tid; i < 2 * 64 * 65; i += NTHREADS) PA[i] = 0.f;
    }
    int tq[2]; bf16x8 qf[2][4]; float gate[2][3];
#pragma unroll
    for (int nt = 0; nt < 2; ++nt) { tq[nt] = t0 + 8 * w + 4 * nt + (l16 >> 2); const size_t row = (size_t)b * T + tq[nt];
        const bf16_t* qp = PROJ + row * NP + C_AQ + (g * 4 + hh) * 128 + g4 * 8;
#pragma unroll
        for (int kq = 0; kq < 4; ++kq) qf[nt][kq] = *(const bf16x8*)(qp + kq * 32);
#pragma unroll
        for (int br = 0; br < 3; ++br) gate[nt][br] = sigm(GATES[row * 64 + 8 + (g * 4 + hh) * 3 + br]); }
    f32x4 O[8][2];
    float mrun[2], lrun[2], invl[2] = {0.f, 0.f};
    unsigned long long selm[2] = {0ull, 0ull};
    u32x4 kr[2], vr[2];
    TileDesc td;
#define O_ZERO() do { _Pragma("unroll") for (int dt = 0; dt < 8; ++dt) { O[dt][0] = (f32x4){0.f, 0.f, 0.f, 0.f}; O[dt][1] = O[dt][0]; } } while (0)
    const int ncmp = ((t0 + 32) >> 10) + 1 > 4 ? 4 : ((t0 + 32) >> 10) + 1;
    const bf16_t* KC = (const bf16_t*)(ws + WS_KC) + (size_t)bg * 256 * 128; const bf16_t* VCT = (const bf16_t*)(ws + WS_VCT) + (size_t)bg * 128 * 256;
    td.kstr = 128; td.vstr = 256; td.kstep = 16; td.wlim = 1 << 30; td.selj = -1;
    mrun[0] = mrun[1] = NEGL; lrun[0] = lrun[1] = 0.f;
    __syncthreads();
    for (int pass = 0; pass < 2; ++pass) {
        if (pass == 1) {
#pragma unroll
            for (int nt = 0; nt < 2; ++nt) { float l = lrun[nt]; l += __shfl_xor(l, 16); l += __shfl_xor(l, 32); invl[nt] = l > 0.f ? 1.0f / l : 0.f; }
            O_ZERO();
        }
        for (int kt = 0; kt < ncmp; ++kt) {
            td.K = KC + (size_t)kt * 64 * 128; td.V = VCT + kt * 64; td.kp0 = 1024 * kt + 31;
            nsa_load(td, tid, kr, vr); nsa_store(Kb0, Vb0, tid, kr, vr);
            __syncthreads();
            if (pass == 0) nsa_tile<0>(Kb0, Vb0, TB, td, qf, tq, selm, hh, l16, g4, O, mrun, lrun, invl, PA, PBv, w, kt, t0);
            else nsa_tile<1>(Kb0, Vb0, TB, td, qf, tq, selm, hh, l16, g4, O, mrun, lrun, invl, PA, PBv, w, kt, t0);
            __syncthreads();
        }
    }
    bf16_t* MIXA = (bf16_t*)(ws + WS_HB) + 2048 + (g * 4 + hh) * 128 + 4 * g4;
#pragma unroll
    for (int nt = 0; nt < 2; ++nt) { const float c = gate[nt][0]; bf16_t* mp = MIXA + ((size_t)b * T + tq[nt]) * D;
#pragma unroll
        for (int dt = 0; dt < 8; ++dt) { u32x2 o; o.x = pk_bf16(O[dt][nt][0] * c, O[dt][nt][1] * c); o.y = pk_bf16(O[dt][nt][2] * c, O[dt][nt][3] * c); *(u32x2*)(mp + 16 * dt) = o; } }
    {
        unsigned long long uni = 0ull;
        for (int ti = 0; ti < 8; ++ti) { const int tok = 8 * w + ti, j = lane;
            const bool valid = j <= qb, forced = (j == 0) || (j == qb) || (j == qb - 1);
            const float score = valid ? (PA[tok * 65 + j] + PBv[tok * 65 + j]) + (forced ? 1000.f : 0.f) : -1.f;
            int rank = 0;
#pragma unroll
            for (int k = 0; k < 64; ++k) { const float sk = __int_as_float(__builtin_amdgcn_readlane(__float_as_int(score), k)); rank += (sk > score || (sk == score && k < j)) ? 1 : 0; }
            const unsigned long long msk = __ballot(valid && rank < 16);
            if (lane == 0) SELM[tok] = msk;
            uni |= msk; }
        if (lane == 0) UNI[w] = uni;
    }
    __syncthreads();
    unsigned long long uni = 0ull;
#pragma unroll
    for (int i = 0; i < 8; ++i) uni |= UNI[i];
    selm[0] = SELM[8 * w + (l16 >> 2)]; selm[1] = SELM[8 * w + 4 + (l16 >> 2)];
    for (int br = 1; br < 3; ++br) {
        unsigned long long rem;
        if (br == 1) { rem = uni; td.kstr = NP; td.vstr = T; td.kstep = 1; td.wlim = 1 << 30; }
        else { const int lo = qb >= 8 ? 0 : 8 - qb; rem = (0x1ffull >> lo) << lo; td.kstr = NP; td.vstr = T; td.kstep = 1; td.wlim = 512; td.selj = -1; }
        const bf16_t* Kbase = PROJ + (size_t)b * T * NP + (br == 1 ? C_SK : C_WK) + g * 128;
        const bf16_t* Vbase = (const bf16_t*)(ws + (br == 1 ? WS_SVT : WS_WVT)) + (size_t)bg * 128 * T;
        mrun[0] = mrun[1] = NEGL; lrun[0] = lrun[1] = 0.f; O_ZERO();
        int j = __builtin_ctzll(rem); rem &= rem - 1;
        { const int s0 = (br == 1) ? 64 * j : t0 - 512 + 64 * j; td.K = Kbase + (size_t)s0 * NP; td.V = Vbase + s0; td.kp0 = s0; if (br == 1) td.selj = j; }
        nsa_load(td, tid, kr, vr); nsa_store(Kb0, Vb0, tid, kr, vr);
        __syncthreads();
        int buf = 0;
        for (;;) {
            const int jn = rem ? __builtin_ctzll(rem) : -1;
            TileDesc tn = td;
            if (jn >= 0) { const int s0 = (br == 1) ? 64 * jn : t0 - 512 + 64 * jn; tn.K = Kbase + (size_t)s0 * NP; tn.V = Vbase + s0; tn.kp0 = s0; if (br == 1) tn.selj = jn; nsa_load(tn, tid, kr, vr); }
            nsa_tile<2>(Kb0 + buf * 64 * 136, Vb0 + buf * 128 * 72, TB, td, qf, tq, selm, hh, l16, g4, O, mrun, lrun, invl, PA, PBv, w, 0, t0);
            if (jn >= 0) nsa_store(Kb0 + (buf ^ 1) * 64 * 136, Vb0 + (buf ^ 1) * 128 * 72, tid, kr, vr);
            __syncthreads();
            if (jn < 0) break;
            rem &= rem - 1; td = tn; buf ^= 1;
        }
#pragma unroll
        for (int nt = 0; nt < 2; ++nt) { float l = lrun[nt]; l += __shfl_xor(l, 16); l += __shfl_xor(l, 32); const float gsel = (br == 1) ? gate[nt][1] : gate[nt][2]; const float c = l > 0.f ? gsel / l : 0.f;
            const size_t row = (size_t)b * T + tq[nt]; bf16_t* mp = MIXA + row * D;
#pragma unroll
            for (int dt = 0; dt < 8; ++dt) { const u32x2 prev = *(const u32x2*)(mp + 16 * dt);
                const float o0 = bflo(prev.x) + O[dt][nt][0] * c, o1 = bfhi(prev.x) + O[dt][nt][1] * c, o2 = bflo(prev.y) + O[dt][nt][2] * c, o3 = bfhi(prev.y) + O[dt][nt][3] * c;
                u32x2 o;
                if (br == 1) { o.x = pk_bf16(o0, o1); o.y = pk_bf16(o2, o3); }
                else { const u32x2 z = *(const u32x2*)(PROJ + row * NP + C_AZ + (g * 4 + hh) * 128 + 16 * dt + 4 * g4);
                    o.x = pk_bf16(o0 * siluf(bflo(z.x)), o1 * siluf(bfhi(z.x))); o.y = pk_bf16(o2 * siluf(bflo(z.y)), o3 * siluf(bfhi(z.y))); }
                *(u32x2*)(mp + 16 * dt) = o; } }
    }
    __syncthreads();
#undef O_ZERO
}

__device__ void phase4(const Args& a) {
    const int tid = threadIdx.x;
    unsigned char* ws = a.ws;
    const bf16_t* PROJ = (const bf16_t*)(ws + WS_PROJ); const bf16_t* HM = (const bf16_t*)(ws + WS_HM); const float* SS = (const float*)(ws + WS_SS);
    bf16_t* MIX = (bf16_t*)(ws + WS_HB); const float* gain = a.in[6];
    for (int it = blockIdx.x * 2 + (tid >> 8); it < MROWS; it += gridDim.x * 2) {
        const int row = it, c8 = (tid & 255) * 8, h = c8 >> 9;
        const f32x4* sp = (const f32x4*)(SS + ((size_t)row * 4 + h) * 32);
        float s = 0.f;
#pragma unroll
        for (int i = 0; i < 8; ++i) { const f32x4 v = sp[i]; s += (v[0] + v[1]) + (v[2] + v[3]); }
        const float rstd = 1.0f / sqrtf(s * (1.0f / 512.f) + 1e-6f);
        const u32x4 hv = *(const u32x4*)(HM + (size_t)row * 2048 + c8), zv = *(const u32x4*)(PROJ + (size_t)row * NP + C_MZ + c8);
        const f32x4 g0 = *(const f32x4*)(gain + c8), g1 = *(const f32x4*)(gain + c8 + 4);
        u32x4 o;
        o.x = pk_bf16(bflo(hv.x) * rstd * g0[0] * siluf(bflo(zv.x)), bfhi(hv.x) * rstd * g0[1] * siluf(bfhi(zv.x)));
        o.y = pk_bf16(bflo(hv.y) * rstd * g0[2] * siluf(bflo(zv.y)), bfhi(hv.y) * rstd * g0[3] * siluf(bfhi(zv.y)));
        o.z = pk_bf16(bflo(hv.z) * rstd * g1[0] * siluf(bflo(zv.z)), bfhi(hv.z) * rstd * g1[1] * siluf(bfhi(zv.z)));
        o.w = pk_bf16(bflo(hv.w) * rstd * g1[2] * siluf(bflo(zv.w)), bfhi(hv.w) * rstd * g1[3] * siluf(bfhi(zv.w)));
        *(u32x4*)(MIX + (size_t)row * D + c8) = o;
    }
}

__device__ void phase6(const Args& a) {
    const int tid = threadIdx.x, lane = tid & 63;
    float* out = a.out; const float* ssq = (const float*)(a.ws + WS_SSQ); const float* gain = a.in[15];
    const int gw = blockIdx.x * 8 + (tid >> 6), nw = gridDim.x * 8;
    for (int row = gw; row < MROWS; row += nw) {
        const float s = wave_sum(ssq[(size_t)row * 64 + lane]);
        const float rstd = 1.0f / sqrtf(s * (1.0f / D) + 1e-6f);
        f32x4* orow = (f32x4*)(out + (size_t)row * D);
#pragma unroll
        for (int i = 0; i < 16; ++i) { const f32x4 g = ((const f32x4*)gain)[lane + 64 * i]; f32x4 v = orow[lane + 64 * i];
            v[0] *= rstd * g[0]; v[1] *= rstd * g[1]; v[2] *= rstd * g[2]; v[3] *= rstd * g[3]; orow[lane + 64 * i] = v; }
    }
}

__global__ void __launch_bounds__(NTHREADS, 2) hymba_fwd(Args a) {
    extern __shared__ __attribute__((aligned(16))) unsigned char lds_raw[];
    LAS unsigned char* lds = (LAS unsigned char*)lds_raw;
    cg::grid_group grid = cg::this_grid();
    const int lo = a.ph_lo, hi = a.ph_hi;
#ifndef PH_MASK
#define PH_MASK 0x7f
#endif
#define IN(k) (((PH_MASK >> (k)) & 1) && lo <= (k) && (k) < hi)
#define SEAM(k) do { if ((k) + 1 < hi) grid.sync(); } while (0)
    if (IN(0)) { phase0(a, lds); SEAM(0); }
    if (IN(1)) {
        pg8::Gemm g{(const bf16_t*)(a.ws + WS_HB), (const bf16_t*)(a.ws + WS_WIN), MROWS, NP, D};
        pg8::StaticOrder S; S.init(MROWS, NP, gridDim.x, blockIdx.x);
        pg8::EpiProj E{(bf16_t*)(a.ws + WS_PROJ), NP};
        pg8::gemm_phase<pg8::EpiProj>(lds, g, S, E);
        gate_gemm(a);
        SEAM(1);
    }
    if (IN(2)) { phase2(a, lds); SEAM(2); }
    if (IN(3)) {
#ifndef NO_MLSTM
        for (int item = blockIdx.x; item < 256; item += gridDim.x) mlstm_item(a, lds, item);
#endif
        __syncthreads();
#ifndef NO_NSA
        for (int p2 = blockIdx.x * 2; p2 < 1024; p2 += gridDim.x * 2)
            for (int u = 0; u < 2; ++u) { const int p = p2 >> 1, bg = p & 15, qq = p >> 4; nsa_unit(a, lds, bg, u ? qq : 63 - qq); }
#endif
        SEAM(3);
    }
    if (IN(4)) { phase4(a); SEAM(4); }
    if (IN(5)) {
        pg8::Gemm g{(const bf16_t*)(a.ws + WS_HB), (const bf16_t*)(a.ws + WS_WOUT), MROWS, D, D};
        pg8::StaticOrder S; S.init(MROWS, D, gridDim.x, blockIdx.x);
        pg8::EpiOut E{a.in[0], a.out, (float*)(a.ws + WS_SSQ)};
        pg8::gemm_phase<pg8::EpiOut>(lds, g, S, E);
        SEAM(5);
    }
    if (IN(6)) { phase6(a); }
#undef IN
#undef SEAM
}

extern "C" void kernel_launch(void* const* d_in, const int* in_sizes, int n_in, void* d_out, int out_size, void* d_ws, size_t ws_size, hipStream_t stream) {
    static int grid = 0;
    if (grid == 0) {
        if (n_in != 16 || ws_size < WS_END) { fprintf(stderr, "kernel_launch: bad inputs (n_in %d, ws %zu, need %zu)\n", n_in, ws_size, (size_t)WS_END); grid = -1; return; }
        int dev = 0, cus = 0, per_cu = 0;
        (void)hipGetDevice(&dev);
        (void)hipDeviceGetAttribute(&cus, hipDeviceAttributeMultiprocessorCount, dev);
        if (hipFuncSetAttribute((const void*)hymba_fwd, hipFuncAttributeMaxDynamicSharedMemorySize, LDS_BYTES) != hipSuccess) { fprintf(stderr, "kernel_launch: hipFuncSetAttribute failed\n"); grid = -1; return; }
        if (hipOccupancyMaxActiveBlocksPerMultiprocessor(&per_cu, (const void*)hymba_fwd, NTHREADS, LDS_BYTES) != hipSuccess || per_cu < 1) { fprintf(stderr, "kernel_launch: occupancy query says %d\n", per_cu); per_cu = 1; }
        (void)hipGetLastError();
        grid = cus * 1;
    }
    if (grid < 0) return;
    Args a{};
    for (int i = 0; i < 16; ++i) a.in[i] = (const float*)d_in[i];
    a.out = (float*)d_out; a.ws = (unsigned char*)d_ws;
#if N_LAUNCH_SPLIT
    for (int ph = 0; ph < 7; ++ph) { a.ph_lo = ph; a.ph_hi = ph + 1; hipLaunchKernelGGL(hymba_fwd, dim3(grid), dim3(NTHREADS), LDS_BYTES, stream, a); }
#else
    a.ph_lo = 0; a.ph_hi = 7;
    void* args[] = {&a};
    hipError_t e = hipLaunchCooperativeKernel((const void*)hymba_fwd, dim3(grid), dim3(NTHREADS), args, LDS_BYTES, stream);
    if (e != hipSuccess) fprintf(stderr, "cooperative launch failed: %s (grid %d)\n", hipGetErrorString(e), grid);
#endif
}
```

```cpp
#include <hip/hip_runtime.h>
#include <hip/hip_cooperative_groups.h>
#include <cstdio>
namespace cg = cooperative_groups;

#ifndef REP_P0
#define REP_P0 1
#endif
#ifndef REP_P1
#define REP_P1 1
#endif
#ifndef REP_P2
#define REP_P2 1
#endif
#ifndef REP_ML
#define REP_ML 1
#endif
#ifndef REP_NSA
#define REP_NSA 1
#endif
#ifndef REP_P5
#define REP_P5 1
#endif
#ifndef N_LAUNCH_SPLIT
#define N_LAUNCH_SPLIT 0
#endif

#define LAS __attribute__((address_space(3)))
typedef unsigned short bf16_t;
typedef short bf16x8 __attribute__((ext_vector_type(8)));
typedef short bf16x4 __attribute__((ext_vector_type(4)));
typedef float f32x4 __attribute__((ext_vector_type(4)));
typedef unsigned u32x4 __attribute__((ext_vector_type(4)));
typedef unsigned u32x2 __attribute__((ext_vector_type(2)));

constexpr int NB = 4, T = 4096, D = 4096, MROWS = NB * T;
constexpr int NP = 15360;
constexpr int NWIN = 15424;
constexpr int W_IN_COLS = 15416;
constexpr int C_MQ = 0, C_MK = 1024, C_MV = 2048, C_MO = 4096, C_MZ = 6144, C_AQ = 8192, C_CK = 10240, C_CV = 10752,
              C_SK = 11264, C_SV = 11776, C_WK = 12288, C_WV = 12800, C_AZ = 13312;
constexpr int NTHREADS = 512;
constexpr int LDS_BYTES = 147456;

#define XCD_BAR_WORDS 3456
constexpr size_t WS_HB = 0;
constexpr size_t WS_WIN = WS_HB + (size_t)MROWS * D * 2;
constexpr size_t WS_WOUT = WS_WIN + (size_t)NWIN * D * 2;
constexpr size_t WS_PROJ = WS_WOUT + (size_t)D * D * 2;
constexpr size_t WS_GATES = WS_PROJ + (size_t)MROWS * NP * 2;
constexpr size_t WS_QKC = WS_GATES + (size_t)MROWS * 64 * 4;
constexpr size_t WS_SVT = WS_QKC + (size_t)MROWS * 2048 * 2;
constexpr size_t WS_WVT = WS_SVT + (size_t)16 * 128 * 4096 * 2;
constexpr size_t WS_KC = WS_WVT + (size_t)16 * 128 * 4096 * 2;
constexpr size_t WS_VCT = WS_KC + (size_t)16 * 256 * 128 * 2;
constexpr size_t WS_W1T = WS_VCT + (size_t)16 * 256 * 128 * 2;
constexpr size_t WS_W2T = WS_W1T + (size_t)2 * 128 * 4096 * 2;
constexpr size_t WS_PB = WS_W2T + (size_t)2 * 128 * 128 * 2;
constexpr size_t WS_HM = WS_PB + 1024;
constexpr size_t WS_SS = WS_HM + (size_t)MROWS * 2048 * 2;
constexpr size_t WS_SSQ = WS_SS + (size_t)MROWS * 128 * 4;
constexpr size_t WS_END = WS_SSQ + (size_t)MROWS * 64 * 4;
constexpr size_t WS_KT = WS_END;
constexpr size_t WS_END2 = WS_KT + (size_t)4 * 1024 * T * 2;
constexpr size_t WS_BAR = WS_END2 + 256;
constexpr size_t WS_END3 = WS_BAR + (size_t)XCD_BAR_WORDS * 4;
static_assert(WS_END3 <= ((size_t)1 << 30), "workspace map must fit 1 GiB");

struct Args { const float* in[16]; float* out; unsigned char* ws; int ph_lo, ph_hi; };

__device__ __forceinline__ unsigned pk_bf16(float lo, float hi) { unsigned r; asm("v_cvt_pk_bf16_f32 %0, %1, %2" : "=v"(r) : "v"(lo), "v"(hi)); return r; }
__device__ __forceinline__ bf16_t f2bf(float f) { return (bf16_t)(pk_bf16(f, 0.f) & 0xffffu); }
__device__ __forceinline__ float bf2f(unsigned b) { return __uint_as_float(b << 16); }
__device__ __forceinline__ float bflo(unsigned w) { return __uint_as_float(w << 16); }
__device__ __forceinline__ float bfhi(unsigned w) { return __uint_as_float(w & 0xffff0000u); }
__device__ __forceinline__ float wave_sum(float v) {
#pragma unroll
    for (int o = 32; o >= 1; o >>= 1) v += __shfl_xor(v, o);
    return v;
}
__device__ __forceinline__ float colgroup_max(float x) {
    const unsigned xi = __float_as_uint(x);
    const auto r = __builtin_amdgcn_permlane32_swap(xi, xi, false, false);
    const float m1 = fmaxf(__uint_as_float(r[0]), __uint_as_float(r[1]));
    const unsigned mi = __float_as_uint(m1);
    const auto r2 = __builtin_amdgcn_permlane16_swap(mi, mi, false, false);
    return fmaxf(__uint_as_float(r2[0]), __uint_as_float(r2[1]));
}
__device__ __forceinline__ float siluf(float x) { return x / (1.f + __expf(-x)); }
__device__ __forceinline__ float sigm(float x) { return 1.f / (1.f + __expf(-x)); }
__device__ __forceinline__ f32x4 mfma16(bf16x8 a, bf16x8 b, f32x4 c) { return __builtin_amdgcn_mfma_f32_16x16x32_bf16(a, b, c, 0, 0, 0); }
__device__ __forceinline__ bf16x8 as_bf16x8(u32x4 v) { union { u32x4 u; bf16x8 b; } x; x.u = v; return x.b; }

#define XB_TMO      128
#define XB_XCNT(j)  (256  + 64 * (j))
#define XB_XSUB(j)  (1280 + 64 * (j))
#define XB_XGEN(j)  (2304 + 64 * (j))
#define XB_TOP      3328
#define XB_TOPGEN   3392
#define XB_SPIN_CAP (1u << 18)
__device__ __forceinline__ unsigned xb_ld(unsigned* p)              { return __hip_atomic_load(p, __ATOMIC_RELAXED, __HIP_MEMORY_SCOPE_AGENT); }
__device__ __forceinline__ unsigned xb_add(unsigned* p, unsigned v) { return __hip_atomic_fetch_add(p, v, __ATOMIC_RELAXED, __HIP_MEMORY_SCOPE_AGENT); }
__device__ __forceinline__ unsigned xb_xcc_id() { return (unsigned)__builtin_amdgcn_s_getreg((3 << 11) | 20) & 0xFu; }
#define XB_SPIN(cond, bar) do { unsigned _sp = 0; while (cond) { __builtin_amdgcn_s_sleep(1); \
    if ((++_sp & 255u) == 0u) { if (xb_ld(&(bar)[XB_TMO])) break; if (_sp > XB_SPIN_CAP) { atomicAdd(&(bar)[XB_TMO], 1u); break; } } } } while (0)
struct XcdBarrier { unsigned* bar; unsigned x; volatile LAS unsigned* st; };
__device__ __forceinline__ XcdBarrier xcd_barrier_post(unsigned* bar, volatile LAS unsigned* st) {
    XcdBarrier b; b.bar = bar; b.x = xb_xcc_id(); b.st = st;
    if (threadIdx.x == 0) (void)xb_add(&bar[XB_XCNT(b.x)], 1u);
    return b;
}
__device__ __forceinline__ void xcd_barrier_complete(unsigned* bar, unsigned x, unsigned& nloc, unsigned& nx) {
    const unsigned G = gridDim.x * gridDim.y * gridDim.z;
    unsigned sum, cnt, mine, sp = 0u;
    for (;;) {
        sum = 0u; cnt = 0u; mine = 0u;
#pragma unroll
        for (unsigned j = 0; j < 16; ++j) { const unsigned c = xb_ld(&bar[XB_XCNT(j)]); sum += c; cnt += (c > 0u) ? 1u : 0u; mine = (j == x) ? c : mine; }
        if (sum == G) break;
        __builtin_amdgcn_s_sleep(1);
        if ((++sp & 255u) == 0u) { if (xb_ld(&bar[XB_TMO])) break; if (sp > XB_SPIN_CAP) { atomicAdd(&bar[XB_TMO], 1u); break; } }
    }
    nloc = mine > 0u ? mine : 1u; nx = cnt > 0u ? cnt : 1u;
}
__device__ __forceinline__ void xcd_barrier(const XcdBarrier& b) {
    asm volatile("s_waitcnt vmcnt(0)" ::: "memory");
    __syncthreads();
    if (threadIdx.x == 0) {
        unsigned* bar = b.bar;
        __builtin_amdgcn_s_waitcnt(0);
        unsigned nloc = b.st[0], nx = b.st[1];
        if (nloc == 0u) { xcd_barrier_complete(bar, b.x, nloc, nx); b.st[0] = nloc; b.st[1] = nx; }
        const unsigned old = xb_add(&bar[XB_XSUB(b.x)], 1u);
        const unsigned gen = old / nloc;
        if (old + 1u == (gen + 1u) * nloc) {
            __builtin_amdgcn_fence(__ATOMIC_RELEASE, "agent");
            asm volatile("s_waitcnt vmcnt(0)" ::: "memory");
            const unsigned og = xb_add(&bar[XB_TOP], 1u);
            const unsigned tg = og / nx;
            if (og + 1u == (tg + 1u) * nx) xb_add(&bar[XB_TOPGEN], 1u);
            else XB_SPIN(xb_ld(&bar[XB_TOPGEN]) == tg, bar);
            __builtin_amdgcn_fence(__ATOMIC_ACQUIRE, "agent");
            xb_add(&bar[XB_XGEN(b.x)], 1u);
            asm volatile("s_waitcnt vmcnt(0)" ::: "memory");
        } else {
            XB_SPIN(xb_ld(&bar[XB_XGEN(b.x)]) == gen, bar);
            __builtin_amdgcn_fence(__ATOMIC_ACQUIRE, "agent");
            asm volatile("s_waitcnt vmcnt(0)" ::: "memory");
        }
    }
    __syncthreads();
}

namespace pg8 {
constexpr int BM = 256, BK = 64, HALF = 128, HTB = HALF * BK * 2, STAGE_BYTES = 8 * HTB, NXCD = 8, WGM = 8;
__host__ __device__ __forceinline__ int lds_byte(int r, int c) { const int st = (r >> 4) * 2 + (c >> 5), rr = r & 15, cc = c & 31, ob = rr * 64 + cc * 2; return st * 1024 + (ob ^ (((ob >> 9) & 1) << 5)); }
__host__ __device__ __forceinline__ void stage_rc(int b, int& R, int& C) { const int st = b / 1024, sb = b % 1024, swz = sb ^ (((sb >> 9) & 1) << 5); R = (st >> 1) * 16 + swz / 64; C = (st & 1) * 32 + (swz % 64) / 2; }
__host__ __device__ __forceinline__ int perm32(int rho) { const int n = rho >> 4, i = rho & 15; return 8 * (i >> 2) + 4 * n + (i & 3); }
struct Unit { int pm, pn; };
struct Gemm { const bf16_t* A; const bf16_t* Bt; int M, N, K; };
struct StaticOrder {
    int nM, nN, nwg, G, c;
    __device__ void init(int M, int N, int G_, int c_) { nM = M / BM; nN = N / BM; nwg = nM * nN; G = G_; c = c_; }
    __device__ bool next(int i, Unit& u) const {
        const long L = (long)i * G + c; if (L >= nwg) return false;
        int wgid = (int)L; { const int q = nwg / NXCD, r = nwg % NXCD, xcd = wgid % NXCD, off = wgid / NXCD; wgid = (xcd < r ? xcd * (q + 1) : r * (q + 1) + (xcd - r) * q) + off; }
        const int nig = WGM * nN, gid = wgid / nig, fm = gid * WGM, gsz = (nM - fm) < WGM ? (nM - fm) : WGM;
        u.pm = fm + ((wgid % nig) % gsz); u.pn = (wgid % nig) / gsz; return true;
    }
};

template <class Epi, bool ALIGN_EPI = true, bool SP2 = true>
__device__ __forceinline__ void gemm_phase(LAS unsigned char* lds, const Gemm g, const StaticOrder& S, const Epi& E) {
    const int tid = threadIdx.x, wid = __builtin_amdgcn_readfirstlane(tid >> 6), lane = tid & 63, wr = wid >> 2, wc = wid & 3, fr = lane & 15, fq = lane >> 4;
    const int K = g.K, nt = K / BK;
    unsigned voffA[2], voffB[2];
#pragma unroll
    for (int i = 0; i < 2; ++i) { int R, C; stage_rc(tid * 16 + i * 8192, R, C); const int Rb = Epi::PERM ? ((R & ~31) + perm32(R & 31)) : R;
        voffA[i] = (unsigned)(R * K + C) * 2u; voffB[i] = (unsigned)(Rb * K + C) * 2u; }
    const size_t kstep = (size_t)(BK * 2);
    const size_t hstep = (size_t)HALF * K * 2;
    const size_t tstep = 2 * hstep;
    const unsigned ldsw = (unsigned)wid * 1024u;
    const int aoff = lds_byte(wr * 64 + fr, fq * 8), boff = lds_byte(wc * 32 + fr, fq * 8);
#define PG8_SA(b, h) (((b) * 2 + (h)) * HTB)
#define PG8_SB(b, h) ((4 + (b) * 2 + (h)) * HTB)
#define PG8_STAGE(bufoff, gbase, voff) do { _Pragma("unroll") for (int _i = 0; _i < 2; ++_i) \
        __builtin_amdgcn_global_load_lds((const unsigned*)((const char*)(gbase) + (voff)[_i]), (LAS unsigned*)(lds + (bufoff) + ldsw + _i * 8192), 16, 0, 0); } while (0)
#define PG8_LDA(dst, b, h) do { _Pragma("unroll") for (int m = 0; m < 4; ++m) _Pragma("unroll") for (int k = 0; k < 2; ++k) dst[m][k] = *(const LAS bf16x8*)(lds + PG8_SA(b, h) + aoff + m * 2048 + k * 1024); } while (0)
#define PG8_LDB(dst, b, h) do { _Pragma("unroll") for (int n = 0; n < 2; ++n) _Pragma("unroll") for (int k = 0; k < 2; ++k) dst[n][k] = *(const LAS bf16x8*)(lds + PG8_SB(b, h) + boff + n * 2048 + k * 1024); } while (0)
#define PG8_MMA(ai, bj, At, Bt) do { __builtin_amdgcn_s_setprio(1); _Pragma("unroll") for (int m = 0; m < 4; ++m) _Pragma("unroll") for (int n = 0; n < 2; ++n) _Pragma("unroll") for (int k = 0; k < 2; ++k) \
        acc[ai][bj][m][n] = __builtin_amdgcn_mfma_f32_16x16x32_bf16(Bt[n][k], At[m][k], acc[ai][bj][m][n], 0, 0, 0); __builtin_amdgcn_s_setprio(0); } while (0)
#define PG8_WAIT_V(n) asm volatile("s_waitcnt vmcnt(" #n ")" ::: "memory")
#define PG8_WAIT_L(n) asm volatile("s_waitcnt lgkmcnt(" #n ")" ::: "memory")
#define PG8_BAR __builtin_amdgcn_s_barrier()
#define PG8_SCHED __builtin_amdgcn_sched_barrier(0)
    Unit cur, nxt; int ui = 0;
    if (!S.next(0, cur)) return;
    f32x4 acc[2][2][4][2];
#pragma unroll
    for (int a = 0; a < 2; ++a)
#pragma unroll
        for (int b = 0; b < 2; ++b)
#pragma unroll
            for (int m = 0; m < 4; ++m)
#pragma unroll
                for (int n = 0; n < 2; ++n) acc[a][b][m][n] = (f32x4){0.f, 0.f, 0.f, 0.f};
    bf16x8 At[4][2], B0[2][2], B1[2][2];
    const char* cA = (const char*)g.A + (size_t)cur.pm * tstep; const char* cB = (const char*)g.Bt + (size_t)cur.pn * tstep;
    if constexpr (SP2) {
        PG8_STAGE(PG8_SB(0, 0), cB, voffB); PG8_STAGE(PG8_SB(0, 1), cB + hstep, voffB); PG8_STAGE(PG8_SA(0, 0), cA, voffA); PG8_STAGE(PG8_SA(0, 1), cA + hstep, voffA);
        if (wr == 1) PG8_BAR;
        PG8_WAIT_V(2); PG8_BAR;
        PG8_STAGE(PG8_SB(1, 0), cB + kstep, voffB); PG8_STAGE(PG8_SA(1, 0), cA + kstep, voffA); PG8_STAGE(PG8_SB(1, 1), cB + hstep + kstep, voffB);
        PG8_WAIT_V(6); PG8_BAR;
    } else {
    PG8_STAGE(PG8_SB(0, 0), cB, voffB); PG8_STAGE(PG8_SA(0, 0), cA, voffA); PG8_STAGE(PG8_SB(0, 1), cB + hstep, voffB); PG8_STAGE(PG8_SA(0, 1), cA + hstep, voffA);
    if (wr == 1) PG8_BAR;
    PG8_WAIT_V(4); PG8_BAR;
    PG8_STAGE(PG8_SB(1, 0), cB + kstep, voffB); PG8_STAGE(PG8_SA(1, 0), cA + kstep, voffA); PG8_STAGE(PG8_SB(1, 1), cB + hstep + kstep, voffB);
    PG8_WAIT_V(6); PG8_BAR;
    }
    for (;;) {
        const bool has_next = S.next(ui + 1, nxt);
        const char* nA = has_next ? (const char*)g.A + (size_t)nxt.pm * tstep : cA; const char* nB = has_next ? (const char*)g.Bt + (size_t)nxt.pn * tstep : cB;
        for (int t = 0; t < nt; t += 2) {
            const bool last = (t == nt - 2);
            const char* a1 = cA + (size_t)(t + 1) * kstep;
            const char* a2 = last ? nA : cA + (size_t)(t + 2) * kstep; const char* b2 = last ? nB : cB + (size_t)(t + 2) * kstep;
            const char* a3 = a2 + kstep; const char* b3 = b2 + kstep;
            if constexpr (SP2) {
            PG8_LDB(B0, 0, 0); PG8_LDB(B1, 0, 1); PG8_SCHED; PG8_LDA(At, 0, 0); PG8_STAGE(PG8_SA(1, 1), a1 + hstep, voffA);
            PG8_WAIT_V(8); PG8_WAIT_L(0); PG8_BAR; PG8_MMA(0, 0, At, B0); PG8_MMA(0, 1, At, B1); PG8_BAR; PG8_SCHED;
            PG8_LDA(At, 0, 1); PG8_STAGE(PG8_SB(0, 0), b2, voffB); PG8_STAGE(PG8_SB(0, 1), b2 + hstep, voffB); PG8_STAGE(PG8_SA(0, 0), a2, voffA);
            PG8_WAIT_V(8); PG8_WAIT_L(0); PG8_BAR; PG8_MMA(1, 0, At, B0); PG8_MMA(1, 1, At, B1); PG8_BAR; PG8_SCHED;
            PG8_LDB(B0, 1, 0); PG8_LDB(B1, 1, 1); PG8_SCHED; PG8_LDA(At, 1, 0); PG8_STAGE(PG8_SA(0, 1), a2 + hstep, voffA);
            PG8_WAIT_V(8); PG8_WAIT_L(0); PG8_BAR; PG8_MMA(0, 0, At, B0); PG8_MMA(0, 1, At, B1); PG8_BAR; PG8_SCHED;
            PG8_LDA(At, 1, 1); PG8_STAGE(PG8_SB(1, 0), b3, voffB); PG8_STAGE(PG8_SB(1, 1), b3 + hstep, voffB); PG8_STAGE(PG8_SA(1, 0), a3, voffA);
            PG8_WAIT_V(8); PG8_WAIT_L(0); PG8_BAR; PG8_MMA(1, 0, At, B0); PG8_MMA(1, 1, At, B1); PG8_BAR; PG8_SCHED;
            } else {
            PG8_LDB(B0, 0, 0); PG8_SCHED; PG8_LDA(At, 0, 0); PG8_STAGE(PG8_SA(1, 1), a1 + hstep, voffA);
            PG8_WAIT_L(8); PG8_BAR; PG8_WAIT_L(0); PG8_MMA(0, 0, At, B0); PG8_BAR; PG8_SCHED;
            PG8_LDB(B1, 0, 1); PG8_STAGE(PG8_SB(0, 0), b2, voffB);
            PG8_BAR; PG8_WAIT_L(0); PG8_MMA(0, 1, At, B1); PG8_BAR;
            PG8_LDA(At, 0, 1); PG8_STAGE(PG8_SA(0, 0), a2, voffA);
            PG8_BAR; PG8_WAIT_L(0); PG8_MMA(1, 0, At, B0); PG8_BAR; PG8_SCHED;
            PG8_STAGE(PG8_SB(0, 1), b2 + hstep, voffB);
            PG8_WAIT_V(6); PG8_BAR; PG8_MMA(1, 1, At, B1); PG8_BAR;
            PG8_LDB(B0, 1, 0); PG8_SCHED; PG8_LDA(At, 1, 0); PG8_STAGE(PG8_SA(0, 1), a2 + hstep, voffA);
            PG8_WAIT_L(8); PG8_BAR; PG8_WAIT_L(0); PG8_MMA(0, 0, At, B0); PG8_BAR; PG8_SCHED;
            PG8_LDB(B1, 1, 1); PG8_STAGE(PG8_SB(1, 0), b3, voffB);
            PG8_BAR; PG8_WAIT_L(0); PG8_MMA(0, 1, At, B1); PG8_BAR;
            PG8_LDA(At, 1, 1); PG8_STAGE(PG8_SA(1, 0), a3, voffA);
            PG8_BAR; PG8_WAIT_L(0); PG8_MMA(1, 0, At, B0); PG8_BAR; PG8_SCHED;
            PG8_STAGE(PG8_SB(1, 1), b3 + hstep, voffB);
            PG8_WAIT_V(6); PG8_BAR; PG8_MMA(1, 1, At, B1); PG8_BAR;
            }
        }
        if constexpr (ALIGN_EPI) { if (wr == 0) PG8_BAR; }
        E(acc, cur, wr, wc, fr, fq);
        if (!has_next) break;
#pragma unroll
        for (int a = 0; a < 2; ++a)
#pragma unroll
            for (int b = 0; b < 2; ++b)
#pragma unroll
                for (int m = 0; m < 4; ++m)
#pragma unroll
                    for (int n = 0; n < 2; ++n) acc[a][b][m][n] = (f32x4){0.f, 0.f, 0.f, 0.f};
        cur = nxt; cA = nA; cB = nB; ++ui;
        if constexpr (ALIGN_EPI) { if (wr == 1) PG8_BAR; }
    }
    PG8_WAIT_V(0);
    if constexpr (!ALIGN_EPI) { if (wr == 0) PG8_BAR; }
    PG8_BAR;
#undef PG8_SA
#undef PG8_SB
#undef PG8_STAGE
#undef PG8_LDA
#undef PG8_LDB
#undef PG8_MMA
#undef PG8_WAIT_V
#undef PG8_WAIT_L
#undef PG8_BAR
#undef PG8_SCHED
}

struct EpiProj {
    static constexpr bool PERM = true;
    bf16_t* O; int ldc;
    __device__ __forceinline__ void operator()(const f32x4 (&acc)[2][2][4][2], const Unit& u, int wr, int wc, int fr, int fq) const {
        const int row0 = u.pm * BM + wr * 64 + fr, col0 = u.pn * BM + wc * 32 + 8 * fq;
#pragma unroll
        for (int ai = 0; ai < 2; ++ai)
#pragma unroll
            for (int m = 0; m < 4; ++m) { bf16_t* rowp = O + (size_t)(row0 + ai * HALF + m * 16) * ldc + col0;
#pragma unroll
                for (int bj = 0; bj < 2; ++bj) { const f32x4 v0 = acc[ai][bj][m][0], v1 = acc[ai][bj][m][1];
                    u32x4 w; w.x = pk_bf16(v0[0], v0[1]); w.y = pk_bf16(v0[2], v0[3]); w.z = pk_bf16(v1[0], v1[1]); w.w = pk_bf16(v1[2], v1[3]);
                    *(u32x4*)(rowp + bj * HALF) = w; } }
    }
};
}

__device__ __forceinline__ int map_win(int n) {
    if (n < 8192) return n;
    if (n < 13312) return n + 8;
    if (n < 15360) return n + 56;
    if (n < 15368) return n - 15360 + 8192;
    if (n < 15416) return n - 15368 + 13320;
    return -1;
}
template <bool WIN>
__device__ void transpose_cvt(const float* __restrict__ src, int src_ld, bf16_t* __restrict__ dst, int K, int ntn) {
    const int tid = threadIdx.x, lane = tid & 63, n4 = (lane & 15) * 4, k8 = (lane >> 4) * 8;
    const int nkt = K / 32, total = ntn * nkt, gw = blockIdx.x * 8 + (tid >> 6), nw = gridDim.x * 8;
    for (int it = gw; it < total; it += nw) {
        const int tn = it / nkt, tk = it - tn * nkt, n = tn * 64 + n4;
        const int sc = WIN ? map_win(n) : n;
        f32x4 v[8];
#pragma unroll
        for (int j = 0; j < 8; ++j) v[j] = (sc >= 0) ? *(const f32x4*)(src + (size_t)(tk * 32 + k8 + j) * src_ld + sc) : (f32x4){0.f, 0.f, 0.f, 0.f};
#pragma unroll
        for (int c = 0; c < 4; ++c) { u32x4 w; w.x = pk_bf16(v[0][c], v[1][c]); w.y = pk_bf16(v[2][c], v[3][c]); w.z = pk_bf16(v[4][c], v[5][c]); w.w = pk_bf16(v[6][c], v[7][c]);
            *(u32x4*)(dst + (size_t)(n + c) * K + tk * 32 + k8) = w; }
    }
}

__device__ void phase0(const Args& a, LAS unsigned char* lds) {
    const int tid = threadIdx.x, lane = tid & 63;
    unsigned char* ws = a.ws;
    {
        const int gw = ((tid >> 6) == 0) ? (int)blockIdx.x : 256;
        if (gw < 256) { const int kv = gw >> 7, e = gw & 127; const float* pos = kv ? a.in[10] : a.in[7]; const float* w1 = kv ? a.in[11] : a.in[8];
            float sacc = 0.f;
#pragma unroll 8
            for (int k = lane; k < 4096; k += 64) sacc += pos[k] * w1[(size_t)k * 128 + e];
            sacc = wave_sum(sacc);
            if (lane == 0) ((float*)(ws + WS_PB))[gw] = sacc; }
    }
    {
        const float* x = a.in[0]; const float* gain = a.in[1]; bf16_t* HB = (bf16_t*)(ws + WS_HB);
        const int gw = blockIdx.x * 8 + (tid >> 6), nw = gridDim.x * 8;
        for (int row = gw; row < MROWS; row += nw) {
            const f32x4* xr = (const f32x4*)(x + (size_t)row * D);
            f32x4 v[16]; float ss = 0.f;
#pragma unroll
            for (int i = 0; i < 16; ++i) { v[i] = xr[lane + 64 * i]; ss += (v[i][0] * v[i][0] + v[i][1] * v[i][1]) + (v[i][2] * v[i][2] + v[i][3] * v[i][3]); }
            ss = wave_sum(ss);
            const float rstd = 1.0f / sqrtf(ss * (1.0f / D) + 1e-6f);
#pragma unroll
            for (int i = 0; i < 16; ++i) { const f32x4 g = ((const f32x4*)gain)[lane + 64 * i];
                u32x2 w; w.x = pk_bf16(v[i][0] * rstd * g[0], v[i][1] * rstd * g[1]); w.y = pk_bf16(v[i][2] * rstd * g[2], v[i][3] * rstd * g[3]);
                *(u32x2*)(HB + (size_t)row * D + (lane + 64 * i) * 4) = w; }
        }
    }
    transpose_cvt<true>(a.in[2], W_IN_COLS, (bf16_t*)(ws + WS_WIN), D, NWIN / 64);
    transpose_cvt<false>(a.in[14], D, (bf16_t*)(ws + WS_WOUT), D, D / 64);
    transpose_cvt<false>(a.in[8], 128, (bf16_t*)(ws + WS_W1T), 4096, 2);
    transpose_cvt<false>(a.in[11], 128, (bf16_t*)(ws + WS_W1T) + 128 * 4096, 4096, 2);
    transpose_cvt<false>(a.in[9], 128, (bf16_t*)(ws + WS_W2T), 128, 2);
    transpose_cvt<false>(a.in[12], 128, (bf16_t*)(ws + WS_W2T) + 128 * 128, 128, 2);
}

__device__ void gate_gemm(const Args& a) {
    const int tid = threadIdx.x, lane = tid & 63, l16 = lane & 15, g4 = lane >> 4;
    const bf16_t* HB = (const bf16_t*)(a.ws + WS_HB); const bf16_t* WG = (const bf16_t*)(a.ws + WS_WIN) + (size_t)NP * D;
    float* GATES = (float*)(a.ws + WS_GATES);
    const int gw = blockIdx.x * 8 + (tid >> 6), nw = gridDim.x * 8;
    for (int item = gw; item < 2048; item += nw) {
        const int rg = item >> 1, nh = item & 1;
        const bf16_t* Ap = HB + (size_t)(rg * 16 + l16) * D + g4 * 8;
        const bf16_t* B0 = WG + (size_t)(nh * 32 + l16) * D + g4 * 8;
        const bf16_t* B1 = B0 + (size_t)16 * D;
        f32x4 c0 = (f32x4){0.f, 0.f, 0.f, 0.f}, c1 = c0;
#pragma unroll 8
        for (int ks = 0; ks < 128; ++ks) {
            const bf16x8 av = *(const bf16x8*)(Ap + ks * 32), b0 = *(const bf16x8*)(B0 + ks * 32), b1 = *(const bf16x8*)(B1 + ks * 32);
            c0 = mfma16(av, b0, c0); c1 = mfma16(av, b1, c1);
        }
#pragma unroll
        for (int r = 0; r < 4; ++r) { float* gp = GATES + (size_t)(rg * 16 + g4 * 4 + r) * 64 + nh * 32 + l16; gp[0] = c0[r]; gp[16] = c1[r]; }
    }
}

__device__ void phase2(const Args& a, LAS unsigned char* lds) {
    const int tid = threadIdx.x, lane = tid & 63, wv = tid >> 6, l16 = lane & 15, g4 = lane >> 4;
    unsigned char* ws = a.ws;
    const bf16_t* PROJ = (const bf16_t*)(ws + WS_PROJ);
    {
        const float* wconv = a.in[3]; bf16_t* QKC = (bf16_t*)(ws + WS_QKC); bf16_t* KT = (bf16_t*)(ws + WS_KT);
        LAS bf16_t* tl = (LAS bf16_t*)lds;
        for (int idx = blockIdx.x; idx < 4096; idx += gridDim.x) {
            const int cb = (idx + (idx >> 8)) & 15, rb = idx >> 4, row0 = rb * 64, t = tid >> 3, c16 = (tid & 7) * 16, ch = cb * 128 + c16;
            const int tin = (row0 & (T - 1)) + t;
            const bf16_t* src = PROJ + (size_t)(row0 + t) * NP + ch;
            float y[16];
#pragma unroll
            for (int e = 0; e < 16; ++e) y[e] = 0.f;
#pragma unroll
            for (int j = 0; j < 4; ++j) {
                if (tin - 3 + j >= 0) {
                    const u32x4 ua = *(const u32x4*)(src - (size_t)(3 - j) * NP), ub = *(const u32x4*)(src - (size_t)(3 - j) * NP + 8);
                    const float* wp = wconv + j * 2048 + ch;
                    const f32x4 w0 = *(const f32x4*)wp, w1 = *(const f32x4*)(wp + 4), w2 = *(const f32x4*)(wp + 8), w3 = *(const f32x4*)(wp + 12);
                    y[0] += w0[0] * bflo(ua[0]); y[1] += w0[1] * bfhi(ua[0]); y[2] += w0[2] * bflo(ua[1]); y[3] += w0[3] * bfhi(ua[1]);
                    y[4] += w1[0] * bflo(ua[2]); y[5] += w1[1] * bfhi(ua[2]); y[6] += w1[2] * bflo(ua[3]); y[7] += w1[3] * bfhi(ua[3]);
                    y[8] += w2[0] * bflo(ub[0]); y[9] += w2[1] * bfhi(ub[0]); y[10] += w2[2] * bflo(ub[1]); y[11] += w2[3] * bfhi(ub[1]);
                    y[12] += w3[0] * bflo(ub[2]); y[13] += w3[1] * bfhi(ub[2]); y[14] += w3[2] * bflo(ub[3]); y[15] += w3[3] * bfhi(ub[3]);
                }
            }
            const float osc = (cb >= 8) ? 0.0625f : 1.0f;
#pragma unroll
            for (int e = 0; e < 16; ++e) y[e] = siluf(y[e]) * osc;
            u32x4 o0, o1; o0.x = pk_bf16(y[0], y[1]); o0.y = pk_bf16(y[2], y[3]); o0.z = pk_bf16(y[4], y[5]); o0.w = pk_bf16(y[6], y[7]);
            o1.x = pk_bf16(y[8], y[9]); o1.y = pk_bf16(y[10], y[11]); o1.z = pk_bf16(y[12], y[13]); o1.w = pk_bf16(y[14], y[15]);
            bf16_t* dq = QKC + (size_t)(row0 + t) * 2048 + ch;
            *(u32x4*)dq = o0; *(u32x4*)(dq + 8) = o1;
            if (cb >= 8) {
                *(LAS u32x4*)(tl + t * 136 + c16) = o0; *(LAS u32x4*)(tl + t * 136 + c16 + 8) = o1;
                __syncthreads();
                const int d = tid >> 2, t16 = (tid & 3) * 16; unsigned e[16];
#pragma unroll
                for (int j = 0; j < 16; ++j) e[j] = tl[(t16 + j) * 136 + d];
                u32x4 w0, w1; w0.x = e[0] | (e[1] << 16); w0.y = e[2] | (e[3] << 16); w0.z = e[4] | (e[5] << 16); w0.w = e[6] | (e[7] << 16);
                w1.x = e[8] | (e[9] << 16); w1.y = e[10] | (e[11] << 16); w1.z = e[12] | (e[13] << 16); w1.w = e[14] | (e[15] << 16);
                bf16_t* dst = KT + ((size_t)(row0 >> 12) * 1024 + (cb - 8) * 128 + d) * T + (row0 & (T - 1)) + t16;
                *(u32x4*)dst = w0; *(u32x4*)(dst + 8) = w1;
                __syncthreads();
            }
        }
    }
    {
        LAS bf16_t* tl = (LAS bf16_t*)lds;
        for (int idx = blockIdx.x; idx < 2048; idx += gridDim.x) {
            const bf16_t* src; bf16_t* dst;
            if (idx < 2048) { const int which = idx >> 10, bg = (idx >> 6) & 15, tt = idx & 63, b = bg >> 2, g = bg & 3;
                src = PROJ + (size_t)(b * T + tt * 64) * NP + (which ? C_WV : C_SV) + g * 128;
                dst = (bf16_t*)(ws + (which ? WS_WVT : WS_SVT)) + (size_t)bg * 128 * T + tt * 64; }
#pragma unroll
            for (int i = 0; i < 2; ++i) { const int p = tid + 512 * i, t = p >> 4, d8 = (p & 15) * 8;
                *(LAS u32x4*)(tl + t * 136 + d8) = *(const u32x4*)(src + (size_t)t * NP + d8); }
            __syncthreads();
            { const int d = tid >> 2, t16 = (tid & 3) * 16; unsigned e[16];
#pragma unroll
              for (int j = 0; j < 16; ++j) e[j] = tl[(t16 + j) * 136 + d];
              u32x4 w0, w1; w0.x = e[0] | (e[1] << 16); w0.y = e[2] | (e[3] << 16); w0.z = e[4] | (e[5] << 16); w0.w = e[6] | (e[7] << 16);
              w1.x = e[8] | (e[9] << 16); w1.y = e[10] | (e[11] << 16); w1.z = e[12] | (e[13] << 16); w1.w = e[14] | (e[15] << 16);
              *(u32x4*)(dst + (size_t)d * T + t16) = w0; *(u32x4*)(dst + (size_t)d * T + t16 + 8) = w1; }
            __syncthreads();
        }
    }
    {
        LAS bf16_t* hid = (LAS bf16_t*)lds;
        LAS float* part = (LAS float*)(lds + 8192);
        const float* PB = (const float*)(ws + WS_PB);
        bf16_t* KC = (bf16_t*)(ws + WS_KC); bf16_t* VCT = (bf16_t*)(ws + WS_VCT);
        for (int item = blockIdx.x; item < 512; item += gridDim.x) {
            const int kv = item >> 8, bg = (item >> 4) & 15, ng = item & 15, b = bg >> 2, g = bg & 3;
            const bf16_t* W1 = (const bf16_t*)(ws + WS_W1T) + (size_t)kv * 128 * 4096; const bf16_t* W2 = (const bf16_t*)(ws + WS_W2T) + kv * 128 * 128;
            int n = ng * 16 + l16; if (n > 254) n = 254;
            const bf16_t* Ap = PROJ + (size_t)(b * T + 16 * n + 4 * wv) * NP + (kv ? C_CV : C_CK) + g * 128 + g4 * 8;
            const bf16_t* Bp = W1 + (size_t)l16 * 4096 + (4 * wv) * 128 + g4 * 8;
            f32x4 acc8[8];
#pragma unroll
            for (int et = 0; et < 8; ++et) acc8[et] = (f32x4){0.f, 0.f, 0.f, 0.f};
#pragma unroll 2
            for (int li = 0; li < 4; ++li)
#pragma unroll
                for (int dq = 0; dq < 4; ++dq) { const bf16x8 av = *(const bf16x8*)(Ap + (size_t)li * NP + dq * 32);
#pragma unroll
                    for (int et = 0; et < 8; ++et) acc8[et] = mfma16(av, *(const bf16x8*)(Bp + (size_t)et * 16 * 4096 + li * 128 + dq * 32), acc8[et]); }
#pragma unroll
            for (int et = 0; et < 8; ++et)
#pragma unroll
                for (int r = 0; r < 4; ++r) part[(wv * 16 + 4 * g4 + r) * 132 + 16 * et + l16] = acc8[et][r];
            __syncthreads();
            {
#pragma unroll
                for (int i = 0; i < 4; ++i) { const int idx = tid + 512 * i, row = idx >> 7, e = idx & 127; float sum = 0.f;
#pragma unroll
                    for (int w8 = 0; w8 < 8; ++w8) sum += part[(w8 * 16 + row) * 132 + e];
                    hid[row * 136 + e] = f2bf(siluf(sum + PB[kv * 128 + e])); }
            }
            __syncthreads();
            f32x4 acc2 = (f32x4){0.f, 0.f, 0.f, 0.f};
#pragma unroll
            for (int ks = 0; ks < 4; ++ks) acc2 = mfma16(*(const LAS bf16x8*)(hid + l16 * 136 + ks * 32 + g4 * 8), *(const bf16x8*)(W2 + (16 * wv + l16) * 128 + ks * 32 + g4 * 8), acc2);
            const int f = 16 * wv + l16, nb = ng * 16 + 4 * g4;
            float o[4];
#pragma unroll
            for (int r = 0; r < 4; ++r) o[r] = (nb + r < 255) ? acc2[r] : 0.f;
            if (kv == 0) {
#pragma unroll
                for (int r = 0; r < 4; ++r) KC[((size_t)bg * 256 + nb + r) * 128 + f] = f2bf(o[r]);
            } else { u32x2 w; w.x = pk_bf16(o[0], o[1]); w.y = pk_bf16(o[2], o[3]); *(u32x2*)(VCT + ((size_t)bg * 128 + f) * 256 + nb) = w; }
            __syncthreads();
        }
    }
}

__device__ __forceinline__ void mlstm_item(const Args& a, LAS unsigned char* lds, int item) {
    const int tid = threadIdx.x, lane = tid & 63, w = __builtin_amdgcn_readfirstlane(tid >> 6), l16 = lane & 15, g4 = lane >> 4;
    const int bh = item >> 4, sl = item & 15, b = bh >> 2, h = bh & 3;
    unsigned char* ws = a.ws;
    const bf16_t* PROJ = (const bf16_t*)(ws + WS_PROJ); const bf16_t* QKC = (const bf16_t*)(ws + WS_QKC); const float* GATES = (const float*)(ws + WS_GATES);
    bf16_t* HM = (bf16_t*)(ws + WS_HM); float* SS = (float*)(ws + WS_SS);
    LAS bf16_t* qs = (LAS bf16_t*)lds;
    LAS bf16_t* ks = qs + 64 * 264;
    LAS bf16_t* kT = ks + 64 * 264;
    LAS bf16_t* vT = kT + 256 * 72;
    LAS bf16_t* vTw = vT + 48 * 72;
    LAS bf16_t* CT = vTw + 48 * 72;
    LAS float* sc = (LAS float*)(CT + 48 * 264);
    LAS bf16_t* Pm = ks;
    for (int i = tid; i < 48 * 264; i += NTHREADS) CT[i] = 0;
    for (int i = tid; i < 16 * 72; i += NTHREADS) { const int r = i / 72; vT[(32 + r) * 72 + (i - r * 72)] = (r == 0) ? (bf16_t)0x3F80 : (bf16_t)0; vTw[(32 + r) * 72 + (i - r * 72)] = 0; }
    f32x4 Cacc[2][3];
#pragma unroll
    for (int i = 0; i < 2; ++i)
#pragma unroll
        for (int j = 0; j < 3; ++j) Cacc[i][j] = (f32x4){0.f, 0.f, 0.f, 0.f};
    float m_st = 0.f;
    const float bi = a.in[4][h], bfg = a.in[5][h];
    u32x4 qreg[4], kreg[4], ktreg[4], vreg; float gi = 0.f, gf = 0.f;
    const bf16_t* KT = (const bf16_t*)(ws + WS_KT) + ((size_t)b * 1024 + h * 256) * T;
    vreg = (u32x4){0, 0, 0, 0};
    const size_t rowbase = (size_t)b * T;
#define ML_PREFETCH(t0_) do { \
        _Pragma("unroll") for (int i = 0; i < 4; ++i) { const int p = tid + 512 * i, l = p >> 5, c8 = (p & 31) * 8; const bf16_t* s_ = QKC + (rowbase + (t0_) + l) * 2048 + h * 256 + c8; \
            qreg[i] = *(const u32x4*)s_; kreg[i] = *(const u32x4*)(s_ + 1024); \
            ktreg[i] = *(const u32x4*)(KT + (size_t)(p >> 3) * T + (t0_) + (p & 7) * 8); } \
        if (tid < 256) { const int l = tid >> 2, c8 = (tid & 3) * 8; vreg = *(const u32x4*)(PROJ + (rowbase + (t0_) + l) * NP + C_MV + h * 512 + sl * 32 + c8); } \
        if (tid < 64) { const float* gp = GATES + (rowbase + (t0_) + tid) * 64; gi = gp[h] + bi; gf = gp[4 + h] + bfg; } } while (0)
    ML_PREFETCH(0);
    __syncthreads();
    for (int c = 0; c < 64; ++c) {
        const int t0 = c * 64;
#pragma unroll
        for (int i = 0; i < 4; ++i) { const int p = tid + 512 * i, l = p >> 5, c8 = (p & 31) * 8;
            *(LAS u32x4*)(qs + l * 264 + c8) = qreg[i]; *(LAS u32x4*)(ks + l * 264 + c8) = kreg[i];
            *(LAS u32x4*)(kT + (p >> 3) * 72 + (p & 7) * 8) = ktreg[i]; }
        if (tid < 256) { const int l = tid >> 2, c8 = (tid & 3) * 8;
#pragma unroll
            for (int j = 0; j < 4; ++j) { vT[(c8 + 2 * j) * 72 + l] = (bf16_t)(vreg[j] & 0xffffu); vT[(c8 + 2 * j + 1) * 72 + l] = (bf16_t)(vreg[j] >> 16); } }
        if (w == 0) {
            const float lf = fminf(gf, 0.f) - log1pf(__expf(-fabsf(gf)));
            float bc = lf;
#pragma unroll
            for (int o = 1; o < 64; o <<= 1) { const float t = __shfl_up(bc, o); if (lane >= o) bc += t; }
            const float av = gi - bc; float pm = av;
#pragma unroll
            for (int o = 1; o < 64; o <<= 1) { const float t = __shfl_up(pm, o); if (lane >= o) pm = fmaxf(pm, t); }
            const float gtot = __shfl(bc, 63);
            const float mrow = fmaxf(m_st, pm), mr63 = __shfl(mrow, 63);
            sc[lane] = av; sc[64 + lane] = mrow; sc[128 + lane] = __expf(m_st - mrow); sc[192 + lane] = __expf(-(bc + mrow)); sc[256 + lane] = __expf(av - mr63);
            if (lane == 0) sc[320] = __expf(m_st - mr63);
            m_st = gtot + mr63;
        }
        if (c + 1 < 64) ML_PREFETCH(t0 + 64);
        __syncthreads();
        const int mt = w & 3, nq = w >> 2;
        unsigned ogr[4];
#pragma unroll
        for (int r = 0; r < 4; ++r) ogr[r] = PROJ[(rowbase + t0 + 16 * mt + 4 * g4 + r) * NP + C_MO + h * 512 + sl * 32 + 16 * nq + l16];
        f32x4 s0 = (f32x4){0.f, 0.f, 0.f, 0.f}, s1 = s0, ci0 = s0, ci2 = s0;
        {
            const LAS bf16_t* ap = qs + (16 * mt + l16) * 264 + g4 * 8;
            const LAS bf16_t* b0p = ks + (16 * (2 * nq) + l16) * 264 + g4 * 8;
            const LAS bf16_t* b1p = b0p + 16 * 264;
            const LAS bf16_t* c0p = CT + (16 * nq + l16) * 264 + g4 * 8;
            const LAS bf16_t* c2p = CT + (32 + l16) * 264 + g4 * 8;
            const bool do0 = (2 * nq <= mt), do1 = (2 * nq + 1 <= mt);
#pragma unroll
            for (int kq = 0; kq < 8; ++kq) {
                const bf16x8 av = *(const LAS bf16x8*)(ap + kq * 32);
                if (do0) s0 = mfma16(av, *(const LAS bf16x8*)(b0p + kq * 32), s0);
                if (do1) s1 = mfma16(av, *(const LAS bf16x8*)(b1p + kq * 32), s1);
                ci0 = mfma16(av, *(const LAS bf16x8*)(c0p + kq * 32), ci0);
                ci2 = mfma16(av, *(const LAS bf16x8*)(c2p + kq * 32), ci2);
            }
        }
        __syncthreads();
        {
#pragma unroll
            for (int r = 0; r < 4; ++r) { const int l = 16 * mt + 4 * g4 + r; const float mr = sc[64 + l];
                { const int s = 16 * (2 * nq) + l16; const float pv = (s <= l) ? s0[r] * __expf(sc[s] - mr) : 0.f; Pm[l * 72 + s] = f2bf(pv); }
                { const int s = 16 * (2 * nq + 1) + l16; const float pv = (s <= l) ? s1[r] * __expf(sc[s] - mr) : 0.f; Pm[l * 72 + s] = f2bf(pv); } }
#pragma unroll
            for (int i = 0; i < 5; ++i) { const int idx = tid + 512 * i; if (idx < 33 * 64) { const int row = idx >> 6, s = idx & 63; const float wt = sc[256 + s];
                vTw[row * 72 + s] = f2bf(row < 32 ? bf2f(vT[row * 72 + s]) * wt : wt); } }
        }
        __syncthreads();
        {
            f32x4 n0 = (f32x4){0.f, 0.f, 0.f, 0.f}, n2 = n0;
#pragma unroll
            for (int kq = 0; kq < 2; ++kq) { const bf16x8 av = *(const LAS bf16x8*)(Pm + (16 * mt + l16) * 72 + kq * 32 + g4 * 8);
                n0 = mfma16(av, *(const LAS bf16x8*)(vT + (16 * nq + l16) * 72 + kq * 32 + g4 * 8), n0);
                n2 = mfma16(av, *(const LAS bf16x8*)(vT + (32 + l16) * 72 + kq * 32 + g4 * 8), n2); }
            const int col = h * 512 + sl * 32 + 16 * nq + l16;
#pragma unroll
            for (int r = 0; r < 4; ++r) { const int l = 16 * mt + 4 * g4 + r; const float il = sc[128 + l];
                const float num = n0[r] + il * ci0[r]; float qn = n2[r] + il * ci2[r]; qn = __shfl(qn, lane & 48);
                const float den = fmaxf(fabsf(qn), sc[192 + l]);
                const size_t row = rowbase + t0 + l;
                const float og = sigm(bf2f(ogr[r]));
                const bf16_t hb = f2bf(og * num / den); HM[row * 2048 + col] = hb;
                float sq = bf2f(hb); sq *= sq;
                sq += __shfl_xor(sq, 1); sq += __shfl_xor(sq, 2); sq += __shfl_xor(sq, 4); sq += __shfl_xor(sq, 8);
                if (l16 == 0) SS[(row * 4 + h) * 32 + sl * 2 + nq] = sq; }
            const float keep = sc[320];
#pragma unroll
            for (int m2 = 0; m2 < 2; ++m2) {
#pragma unroll
                for (int j = 0; j < 3; ++j) Cacc[m2][j] *= keep;
#pragma unroll
                for (int kq = 0; kq < 2; ++kq) { const bf16x8 av = *(const LAS bf16x8*)(kT + (32 * w + 16 * m2 + l16) * 72 + kq * 32 + g4 * 8);
#pragma unroll
                    for (int j = 0; j < 3; ++j) Cacc[m2][j] = mfma16(av, *(const LAS bf16x8*)(vTw + (16 * j + l16) * 72 + kq * 32 + g4 * 8), Cacc[m2][j]); }
#pragma unroll
                for (int j = 0; j < 3; ++j) { u32x2 wv2; wv2.x = pk_bf16(Cacc[m2][j][0], Cacc[m2][j][1]); wv2.y = pk_bf16(Cacc[m2][j][2], Cacc[m2][j][3]);
                    *(LAS u32x2*)(CT + (16 * j + l16) * 264 + 32 * w + 16 * m2 + 4 * g4) = wv2; }
            }
        }
        __syncthreads();
    }
#undef ML_PREFETCH
}

struct TileDesc { const bf16_t* K; size_t kstr; const bf16_t* V; size_t vstr; int kp0, kstep, wlim, selj; };

constexpr float NEGL = -1e30f;
constexpr float QK_SC = 0.08838834764831845f * 1.4426950408889634f;

constexpr int TBN = 1088;
template <int MODE, int NTS>
__device__ __forceinline__ void nsa_tile(const LAS bf16_t* Kt, const LAS bf16_t* Vt, const LAS float* TB, const TileDesc& td, const bf16x8 (&qf)[2][4],
                                         const int (&tq)[2], const LAS unsigned long long* selm, int hh, int l16, int g4,
                                         f32x4 (&O)[8][2], float (&mrun)[2], float (&lrun)[2], const float (&invl)[2],
                                         LAS float* PA, LAS float* PBv, int w, int kt64, int t0, const bool MASKED) {
    const bool far = (t0 - (td.kp0 + 63 * td.kstep)) >= 790;
    const float bfar = TB[(1023 + 64) * 4 + hh];
    const bool alw0 = (td.selj < 0) || ((selm[0] >> td.selj) & 1ull), alw1 = (td.selj < 0) || ((selm[4] >> td.selj) & 1ull);
    constexpr bool any0 = (NTS & 1) != 0, any1 = (NTS & 2) != 0;
#pragma unroll 1
    for (int i = 0; i < 2; ++i) {
        f32x4 S[2][2];
#pragma unroll
        for (int mm = 0; mm < 2; ++mm) { S[mm][0] = (f32x4){0.f, 0.f, 0.f, 0.f}; S[mm][1] = S[mm][0]; }
#pragma unroll
        for (int mm = 0; mm < 2; ++mm)
#pragma unroll
            for (int kq = 0; kq < 4; ++kq) { const bf16x8 av = *(const LAS bf16x8*)(Kt + (32 * i + 16 * mm + l16) * 136 + kq * 32 + g4 * 8);
                if (any0) S[mm][0] = mfma16(av, qf[0][kq], S[mm][0]);
                if (any1) S[mm][1] = mfma16(av, qf[1][kq], S[mm][1]); }
#pragma unroll
        for (int nt = 0; nt < 2; ++nt) {
            const bool allowed = nt ? alw1 : alw0;
            if (!(nt ? any1 : any0)) continue;
            float mx = NEGL;
            if (MASKED) {
#pragma unroll
                for (int mm = 0; mm < 2; ++mm)
#pragma unroll
                    for (int r = 0; r < 4; ++r) {
                        const int kk = 32 * i + 16 * mm + 4 * g4 + r, dist = tq[nt] - (td.kp0 + td.kstep * kk);
                        const bool ok = allowed && dist >= 0 && dist < td.wlim;
                        float bias = bfar;
                        if (!far) { int di = dist < -64 ? -64 : dist; di = di > 1023 ? 1023 : di; bias = TB[(di + 64) * 4 + hh]; }
                        const float lg = ok ? S[mm][nt][r] * QK_SC + bias : NEGL;
                        S[mm][nt][r] = lg; mx = fmaxf(mx, lg);
                    }
            } else {
                if (far) {
#pragma unroll
                    for (int mm = 0; mm < 2; ++mm)
#pragma unroll
                        for (int r = 0; r < 4; ++r) { const float lg = S[mm][nt][r] * QK_SC + bfar; S[mm][nt][r] = lg; mx = fmaxf(mx, lg); }
                } else {
                    const LAS float* tp = TB + ((tq[nt] - td.kp0 - 4 * g4 + 64 - 32 * i - 19) * 4 + hh);
#pragma unroll
                    for (int mm = 0; mm < 2; ++mm)
#pragma unroll
                        for (int r = 0; r < 4; ++r) { const float lg = S[mm][nt][r] * QK_SC + tp[(19 - 16 * mm - r) * 4]; S[mm][nt][r] = lg; mx = fmaxf(mx, lg); }
                }
                if (!allowed) mx = NEGL;
            }
            if (MODE != 1) {
                mx = colgroup_max(mx);
                const float mnew = fmaxf(mrun[nt], mx), alpha = __builtin_amdgcn_exp2f(mrun[nt] - mnew);
                mrun[nt] = mnew; float ps = 0.f;
#pragma unroll
                for (int mm = 0; mm < 2; ++mm)
#pragma unroll
                    for (int r = 0; r < 4; ++r) { const float lg = S[mm][nt][r];
                        const float p = MASKED ? ((lg <= -1e29f) ? 0.f : __builtin_amdgcn_exp2f(lg - mnew)) : (allowed ? __builtin_amdgcn_exp2f(lg - mnew) : 0.f);
                        S[mm][nt][r] = p; ps += p; }
                lrun[nt] = lrun[nt] * alpha + ps;
                if (MODE == 2) {
                    if (__builtin_amdgcn_ballot_w64(alpha != 1.0f) != 0ull) {
#pragma unroll
                        for (int dt = 0; dt < 8; ++dt) O[dt][nt] *= alpha;
                    }
                }
            } else {
                const float mfix = mrun[nt], il = invl[nt];
#pragma unroll
                for (int mm = 0; mm < 2; ++mm) {
#pragma unroll
                    for (int r = 0; r < 4; ++r) { const float lg = S[mm][nt][r]; S[mm][nt][r] = (lg <= -1e29f) ? 0.f : __builtin_amdgcn_exp2f(lg - mfix) * il; }
                    float pa = (S[mm][nt][0] + S[mm][nt][1]) + (S[mm][nt][2] + 0.5f * S[mm][nt][3]), pb = 0.5f * S[mm][nt][3];
                    pa += __shfl_xor(pa, 1); pa += __shfl_xor(pa, 2); pb += __shfl_xor(pb, 1); pb += __shfl_xor(pb, 2);
                    if ((l16 & 3) == 0) { const int tok = 8 * w + 4 * nt + (l16 >> 2), j = 16 * kt64 + 4 * (2 * i + mm) + g4; PA[tok * 65 + j] = pa; if (j + 1 < 64) PBv[tok * 65 + j + 1] = pb; }
                }
            }
        }
        if (MODE != 0) {
            bf16x8 pb[2];
#pragma unroll
            for (int nt = 0; nt < 2; ++nt) { u32x4 u; u.x = pk_bf16(S[0][nt][0], S[0][nt][1]); u.y = pk_bf16(S[0][nt][2], S[0][nt][3]);
                u.z = pk_bf16(S[1][nt][0], S[1][nt][1]); u.w = pk_bf16(S[1][nt][2], S[1][nt][3]); pb[nt] = as_bf16x8(u); }
#pragma unroll
            for (int dt = 0; dt < 8; ++dt) { const LAS bf16_t* vp = Vt + (16 * dt + l16) * 72 + 32 * i + 4 * g4;
                const u32x2 lo = *(const LAS u32x2*)vp, hi = *(const LAS u32x2*)(vp + 16);
                const bf16x8 av = as_bf16x8((u32x4){lo.x, lo.y, hi.x, hi.y});
                if (any0) O[dt][0] = mfma16(av, pb[0], O[dt][0]);
                if (any1) O[dt][1] = mfma16(av, pb[1], O[dt][1]); }
        }
    }
}

__device__ __forceinline__ void nsa_load(const TileDesc& td, int tid, u32x4 (&kr)[2], u32x4 (&vr)[2]) {
#pragma unroll
    for (int i = 0; i < 2; ++i) { const int p = tid + 512 * i;
        kr[i] = *(const u32x4*)(td.K + (size_t)(p >> 4) * td.kstr + (p & 15) * 8);
        vr[i] = *(const u32x4*)(td.V + (size_t)(p >> 3) * td.vstr + (p & 7) * 8); }
}
__device__ __forceinline__ void nsa_store(LAS bf16_t* Kb, LAS bf16_t* Vb, int tid, const u32x4 (&kr)[2], const u32x4 (&vr)[2]) {
#pragma unroll
    for (int i = 0; i < 2; ++i) { const int p = tid + 512 * i;
        *(LAS u32x4*)(Kb + (p >> 4) * 136 + (p & 15) * 8) = kr[i];
        *(LAS u32x4*)(Vb + (p >> 3) * 72 + (p & 7) * 8) = vr[i]; }
}

__device__ __forceinline__ void nsa_unit(const Args& a, LAS unsigned char* lds, int bg, int qb) {
    const int tid = threadIdx.x, lane = tid & 63, w = __builtin_amdgcn_readfirstlane(tid >> 6), l16 = lane & 15, g4 = lane >> 4;
    const int b = bg >> 2, g = bg & 3, t0 = qb * 64, hh = l16 & 3;
    unsigned char* ws = a.ws;
    const bf16_t* PROJ = (const bf16_t*)(ws + WS_PROJ); const float* GATES = (const float*)(ws + WS_GATES);
    LAS bf16_t* Kb0 = (LAS bf16_t*)lds;
    LAS bf16_t* Vb0 = Kb0 + 2 * 64 * 136;
    LAS float* TB = (LAS float*)(Vb0 + 2 * 128 * 72);
    LAS float* PA = TB + 4 * TBN;
    LAS float* PBv = PA + 64 * 65;
    LAS unsigned long long* SELM = (LAS unsigned long long*)(PBv + 64 * 65);
    LAS unsigned long long* UNI = SELM + 64;
    {
        const float* rel = a.in[13];
        for (int i = tid; i < 4 * TBN; i += NTHREADS) { const int h = i & 3, d = (i >> 2) - 64; int bk = d < 0 ? 0 : d;
            if (d >= 16) { bk = 16 + (d >= 21) + (d >= 27) + (d >= 35) + (d >= 46) + (d >= 59) + (d >= 77) + (d >= 99) + (d >= 128) + (d >= 166) + (d >= 216) + (d >= 280) + (d >= 363) + (d >= 470) + (d >= 609) + (d >= 790); }
            TB[i] = rel[bk * 16 + g * 4 + h] * 1.4426950408889634f; }
        for (int i = tid; i < 2 * 64 * 65; i += NTHREADS) PA[i] = 0.f;
    }
    int tq[2]; bf16x8 qf[2][4];
#pragma unroll
    for (int nt = 0; nt < 2; ++nt) { tq[nt] = t0 + 8 * w + 4 * nt + (l16 >> 2); const size_t row = (size_t)b * T + tq[nt];
        const bf16_t* qp = PROJ + row * NP + C_AQ + (g * 4 + hh) * 128 + g4 * 8;
#pragma unroll
        for (int kq = 0; kq < 4; ++kq) qf[nt][kq] = *(const bf16x8*)(qp + kq * 32);
 }
    f32x4 O[8][2];
    float mrun[2], lrun[2], invl[2] = {0.f, 0.f};
    const LAS unsigned long long* selm = SELM + 8 * w + (l16 >> 2);
    u32x4 kr[2], vr[2];
    TileDesc td;
#define O_ZERO() do { _Pragma("unroll") for (int dt = 0; dt < 8; ++dt) { O[dt][0] = (f32x4){0.f, 0.f, 0.f, 0.f}; O[dt][1] = O[dt][0]; } } while (0)
    const int ncmp = ((t0 + 32) >> 10) + 1 > 4 ? 4 : ((t0 + 32) >> 10) + 1;
    const bf16_t* KC = (const bf16_t*)(ws + WS_KC) + (size_t)bg * 256 * 128; const bf16_t* VCT = (const bf16_t*)(ws + WS_VCT) + (size_t)bg * 128 * 256;
    td.kstr = 128; td.vstr = 256; td.kstep = 16; td.wlim = 1 << 30; td.selj = -1;
    mrun[0] = mrun[1] = NEGL; lrun[0] = lrun[1] = 0.f;
    __syncthreads();
    for (int pass = 0; pass < 2; ++pass) {
        if (pass == 1) {
#pragma unroll
            for (int nt = 0; nt < 2; ++nt) { float l = lrun[nt]; l += __shfl_xor(l, 16); l += __shfl_xor(l, 32); invl[nt] = l > 0.f ? 1.0f / l : 0.f; }
            O_ZERO();
        }
        for (int kt = 0; kt < ncmp; ++kt) {
            td.K = KC + (size_t)kt * 64 * 128; td.V = VCT + kt * 64; td.kp0 = 1024 * kt + 31;
            nsa_load(td, tid, kr, vr); nsa_store(Kb0, Vb0, tid, kr, vr);
            __syncthreads();
            if (pass == 0) nsa_tile<0, 3>(Kb0, Vb0, TB, td, qf, tq, selm, hh, l16, g4, O, mrun, lrun, invl, PA, PBv, w, kt, t0, true);
            else nsa_tile<1, 3>(Kb0, Vb0, TB, td, qf, tq, selm, hh, l16, g4, O, mrun, lrun, invl, PA, PBv, w, kt, t0, true);
            __syncthreads();
        }
    }
    bf16_t* MIXA = (bf16_t*)(ws + WS_HB) + 2048 + (g * 4 + hh) * 128 + 4 * g4;
#pragma unroll
    for (int nt = 0; nt < 2; ++nt) { const float c = sigm(GATES[((size_t)b * T + tq[nt]) * 64 + 8 + (g * 4 + hh) * 3]); bf16_t* mp = MIXA + ((size_t)b * T + tq[nt]) * D;
#pragma unroll
        for (int dt = 0; dt < 8; ++dt) { u32x2 o; o.x = pk_bf16(O[dt][nt][0] * c, O[dt][nt][1] * c); o.y = pk_bf16(O[dt][nt][2] * c, O[dt][nt][3] * c); *(u32x2*)(mp + 16 * dt) = o; } }
    {
        unsigned long long uni = 0ull;
        const unsigned long long validmask = (qb >= 63) ? ~0ull : ((1ull << (qb + 1)) - 1ull);
        for (int ti = 0; ti < 8; ++ti) { const int tok = 8 * w + ti, j = lane;
            const bool valid = j <= qb, forced = (j == 0) || (j == qb) || (j == qb - 1);
            const float score = (PA[tok * 65 + j] + PBv[tok * 65 + j]) + (forced ? 1000.f : 0.f);
            const unsigned key = valid ? __float_as_uint(score) : 0u;
            unsigned thr = 0u;
#pragma unroll
            for (int bit = 31; bit >= 0; --bit) { const unsigned cand = thr | (1u << bit); if (__popcll(__ballot(key >= cand)) >= 16) thr = cand; }
            unsigned long long sel = __ballot(key > thr), eq = __ballot(key == thr);
            for (int need = 16 - __popcll(sel); need > 0; --need) { const unsigned long long b = eq & (0ull - eq); sel |= b; eq ^= b; }
            const unsigned long long msk = sel & validmask;
            if (lane == 0) SELM[tok] = msk;
            uni |= msk; }
        if (lane == 0) UNI[w] = uni;
    }
    __syncthreads();
    unsigned long long uni = 0ull;
#pragma unroll
    for (int i = 0; i < 8; ++i) uni |= UNI[i];
    for (int br = 1; br < 3; ++br) {
        unsigned long long rem;
        if (br == 1) { rem = uni; td.kstr = NP; td.vstr = T; td.kstep = 1; td.wlim = 1 << 30; }
        else { const int lo = qb >= 8 ? 0 : 8 - qb; rem = (0x1ffull >> lo) << lo; td.kstr = NP; td.vstr = T; td.kstep = 1; td.wlim = 512; td.selj = -1; }
        const bf16_t* Kbase = PROJ + (size_t)b * T * NP + (br == 1 ? C_SK : C_WK) + g * 128;
        const bf16_t* Vbase = (const bf16_t*)(ws + (br == 1 ? WS_SVT : WS_WVT)) + (size_t)bg * 128 * T;
        mrun[0] = mrun[1] = NEGL; lrun[0] = lrun[1] = 0.f; O_ZERO();
        int j = __builtin_ctzll(rem); rem &= rem - 1;
        { const int s0 = (br == 1) ? 64 * j : t0 - 512 + 64 * j; td.K = Kbase + (size_t)s0 * NP; td.V = Vbase + s0; td.kp0 = s0; if (br == 1) td.selj = j; }
        nsa_load(td, tid, kr, vr); nsa_store(Kb0, Vb0, tid, kr, vr);
        __syncthreads();
        int buf = 0;
        for (;;) {
            const int jn = rem ? __builtin_ctzll(rem) : -1;
            TileDesc tn = td;
            if (jn >= 0) { const int s0 = (br == 1) ? 64 * jn : t0 - 512 + 64 * jn; tn.K = Kbase + (size_t)s0 * NP; tn.V = Vbase + s0; tn.kp0 = s0; if (br == 1) tn.selj = jn; nsa_load(tn, tid, kr, vr); }
            const bool msk = (br == 1) ? (j == qb) : (j == 0 || j == 8);
            {
                const bool a0 = (td.selj < 0) || ((selm[0] >> td.selj) & 1ull), a1 = (td.selj < 0) || ((selm[4] >> td.selj) & 1ull);
                const bool any0 = __builtin_amdgcn_ballot_w64(a0) != 0ull, any1 = __builtin_amdgcn_ballot_w64(a1) != 0ull;
                const LAS bf16_t* kb = Kb0 + buf * 64 * 136; const LAS bf16_t* vb = Vb0 + buf * 128 * 72;
                if (any0 || any1) nsa_tile<2, 3>(kb, vb, TB, td, qf, tq, selm, hh, l16, g4, O, mrun, lrun, invl, PA, PBv, w, 0, t0, msk);
            }
            if (jn >= 0) nsa_store(Kb0 + (buf ^ 1) * 64 * 136, Vb0 + (buf ^ 1) * 128 * 72, tid, kr, vr);
            __syncthreads();
            if (jn < 0) break;
            rem &= rem - 1; td = tn; buf ^= 1; j = jn;
        }
#pragma unroll
        for (int nt = 0; nt < 2; ++nt) { float l = lrun[nt]; l += __shfl_xor(l, 16); l += __shfl_xor(l, 32); const size_t row = (size_t)b * T + tq[nt]; bf16_t* mp = MIXA + row * D;
            const float gsel = sigm(GATES[row * 64 + 8 + (g * 4 + hh) * 3 + br]); const float c = l > 0.f ? gsel / l : 0.f;
#pragma unroll
            for (int dt = 0; dt < 8; ++dt) { const u32x2 prev = *(const u32x2*)(mp + 16 * dt);
                const float o0 = bflo(prev.x) + O[dt][nt][0] * c, o1 = bfhi(prev.x) + O[dt][nt][1] * c, o2 = bflo(prev.y) + O[dt][nt][2] * c, o3 = bfhi(prev.y) + O[dt][nt][3] * c;
                u32x2 o;
                if (br == 1) { o.x = pk_bf16(o0, o1); o.y = pk_bf16(o2, o3); }
                else { const u32x2 z = *(const u32x2*)(PROJ + row * NP + C_AZ + (g * 4 + hh) * 128 + 16 * dt + 4 * g4);
                    o.x = pk_bf16(o0 * siluf(bflo(z.x)), o1 * siluf(bfhi(z.x))); o.y = pk_bf16(o2 * siluf(bflo(z.y)), o3 * siluf(bfhi(z.y))); }
                *(u32x2*)(mp + 16 * dt) = o; } }
    }
    __syncthreads();
#undef O_ZERO
}

__device__ void phase4(const Args& a) {
    const int tid = threadIdx.x, lane = tid & 63;
    unsigned char* ws = a.ws;
    const bf16_t* PROJ = (const bf16_t*)(ws + WS_PROJ); const bf16_t* HM = (const bf16_t*)(ws + WS_HM); const float* SS = (const float*)(ws + WS_SS);
    bf16_t* MIX = (bf16_t*)(ws + WS_HB); const float* gain = a.in[6];
    const int gw = blockIdx.x * 8 + (tid >> 6), nw = gridDim.x * 8;
    for (int it = gw; it < MROWS * 4; it += nw) {
        const int row = it >> 2, h = it & 3, c8 = h * 512 + lane * 8;
        const u32x4 hv = *(const u32x4*)(HM + (size_t)row * 2048 + c8), zv = *(const u32x4*)(PROJ + (size_t)row * NP + C_MZ + c8);
        const float sp = SS[(size_t)it * 32 + (lane & 31)];
        float s = sp; s += __shfl_xor(s, 1); s += __shfl_xor(s, 2); s += __shfl_xor(s, 4); s += __shfl_xor(s, 8); s += __shfl_xor(s, 16);
        const float rstd = 1.0f / sqrtf(s * (1.0f / 512.f) + 1e-6f);
        const f32x4 g0 = *(const f32x4*)(gain + c8), g1 = *(const f32x4*)(gain + c8 + 4);
        u32x4 o;
        o.x = pk_bf16(bflo(hv.x) * rstd * g0[0] * siluf(bflo(zv.x)), bfhi(hv.x) * rstd * g0[1] * siluf(bfhi(zv.x)));
        o.y = pk_bf16(bflo(hv.y) * rstd * g0[2] * siluf(bflo(zv.y)), bfhi(hv.y) * rstd * g0[3] * siluf(bfhi(zv.y)));
        o.z = pk_bf16(bflo(hv.z) * rstd * g1[0] * siluf(bflo(zv.z)), bfhi(hv.z) * rstd * g1[1] * siluf(bfhi(zv.z)));
        o.w = pk_bf16(bflo(hv.w) * rstd * g1[2] * siluf(bflo(zv.w)), bfhi(hv.w) * rstd * g1[3] * siluf(bfhi(zv.w)));
        *(u32x4*)(MIX + (size_t)row * D + c8) = o;
    }
}

__device__ void phase6(const Args& a) {
    const int tid = threadIdx.x, lane = tid & 63;
    float* out = a.out; const float* x = a.in[0]; const float* gain = a.in[15];
    const int gw = blockIdx.x * 8 + (tid >> 6), nw = gridDim.x * 8;
    for (int row = gw; row < MROWS; row += nw) {
        f32x4* orow = (f32x4*)(out + (size_t)row * D); const f32x4* xr = (const f32x4*)(x + (size_t)row * D);
        const u32x2* pr = (const u32x2*)((const bf16_t*)(a.ws + WS_PROJ) + (size_t)row * D);
        f32x4 v[16]; float ss = 0.f;
#pragma unroll
        for (int i = 0; i < 16; ++i) { const u32x2 pv = pr[lane + 64 * i]; const f32x4 xv = xr[lane + 64 * i];
            v[i][0] = bflo(pv.x) + xv[0]; v[i][1] = bfhi(pv.x) + xv[1]; v[i][2] = bflo(pv.y) + xv[2]; v[i][3] = bfhi(pv.y) + xv[3];
            ss += (v[i][0] * v[i][0] + v[i][1] * v[i][1]) + (v[i][2] * v[i][2] + v[i][3] * v[i][3]); }
        ss = wave_sum(ss);
        const float rstd = 1.0f / sqrtf(ss * (1.0f / D) + 1e-6f);
#pragma unroll
        for (int i = 0; i < 16; ++i) { const f32x4 g = ((const f32x4*)gain)[lane + 64 * i]; f32x4 o;
            o[0] = v[i][0] * rstd * g[0]; o[1] = v[i][1] * rstd * g[1]; o[2] = v[i][2] * rstd * g[2]; o[3] = v[i][3] * rstd * g[3]; orow[lane + 64 * i] = o; }
    }
}

__global__ void __launch_bounds__(NTHREADS, 2) hymba_fwd(Args a) {
    extern __shared__ __attribute__((aligned(16))) unsigned char lds_raw[];
    LAS unsigned char* lds = (LAS unsigned char*)lds_raw;
    cg::grid_group grid = cg::this_grid();
    volatile LAS unsigned* xb_st = (volatile LAS unsigned*)(lds + (LDS_BYTES - 16));
    if (threadIdx.x < 4) xb_st[threadIdx.x] = 0u;
    __syncthreads();
    unsigned* xb_words = (unsigned*)(a.ws + WS_BAR);
    XcdBarrier xbar = xcd_barrier_post(xb_words, xb_st);
    if (a.ph_hi > 1000) grid.sync();
    const int lo = a.ph_lo, hi = a.ph_hi;
#ifdef STAMP_SEL
    unsigned long long* stamps = (unsigned long long*)(a.ws + WS_END2);
#define STAMP(k) do { if (blockIdx.x == 0 && threadIdx.x == 0) stamps[k] = __builtin_amdgcn_s_memrealtime(); } while (0)
#else
#define STAMP(k) do { } while (0)
#endif
    STAMP(0);
#ifndef PH_MASK
#define PH_MASK 0x7f
#endif
#define IN(k) (((PH_MASK >> (k)) & 1) && lo <= (k) && (k) < hi)
#define SEAM(k) do { if ((k) + 1 < hi) xcd_barrier(xbar); } while (0)
    if (IN(0)) { for (int rep = 0; rep < REP_P0; ++rep) phase0(a, lds); SEAM(0); STAMP(1); }
    if (IN(1)) { for (int rep = 0; rep < REP_P1; ++rep) {
        pg8::Gemm g{(const bf16_t*)(a.ws + WS_HB), (const bf16_t*)(a.ws + WS_WIN), MROWS, NP, D};
        pg8::StaticOrder S; S.init(MROWS, NP, gridDim.x, blockIdx.x);
        pg8::EpiProj E{(bf16_t*)(a.ws + WS_PROJ), NP};
        pg8::gemm_phase<pg8::EpiProj>(lds, g, S, E);
        gate_gemm(a); }
        SEAM(1); STAMP(2);
    }
    if (IN(2)) { for (int rep = 0; rep < REP_P2; ++rep) phase2(a, lds); SEAM(2); STAMP(3); }
    if (IN(3)) {
#ifndef NO_MLSTM
        for (int rep = 0; rep < REP_ML; ++rep)
        for (int item = blockIdx.x; item < 256; item += gridDim.x) mlstm_item(a, lds, item);
#endif
        __syncthreads();
        STAMP(4);
#ifndef NO_NSA
        for (int rep = 0; rep < REP_NSA; ++rep)
        for (int p2 = blockIdx.x * 2; p2 < 1024; p2 += gridDim.x * 2)
            for (int u = 0; u < 2; ++u) { const int p = p2 >> 1, bg = p & 15, qq = p >> 4; nsa_unit(a, lds, bg, u ? qq : 63 - qq); }
#endif
        SEAM(3); STAMP(5);
    }
    if (IN(4)) { phase4(a); SEAM(4); STAMP(6); }
    if (IN(5)) { for (int rep = 0; rep < REP_P5; ++rep) {
        pg8::Gemm g{(const bf16_t*)(a.ws + WS_HB), (const bf16_t*)(a.ws + WS_WOUT), MROWS, D, D};
        pg8::StaticOrder S; S.init(MROWS, D, gridDim.x, blockIdx.x);
        pg8::EpiProj E{(bf16_t*)(a.ws + WS_PROJ), D};
        pg8::gemm_phase<pg8::EpiProj>(lds, g, S, E); }
        SEAM(5); STAMP(7);
    }
    if (IN(6)) { phase6(a); }
#ifdef STAMP_SEL
    __builtin_amdgcn_fence(__ATOMIC_RELEASE, "agent"); grid.sync(); __builtin_amdgcn_fence(__ATOMIC_ACQUIRE, "agent");
    if (blockIdx.x == 0) { STAMP(8); __syncthreads();
        const unsigned long long k = stamps[STAMP_SEL + 1] - stamps[STAMP_SEL];
        for (unsigned long long i = threadIdx.x; i < k; i += NTHREADS) a.out[i] += 0.0625f; }
#endif
#undef IN
#undef SEAM
}

extern "C" void kernel_launch(void* const* d_in, const int* in_sizes, int n_in, void* d_out, int out_size, void* d_ws, size_t ws_size, hipStream_t stream) {
    static int grid = 0;
    if (grid == 0) {
        if (n_in != 16 || ws_size < WS_END3) { fprintf(stderr, "kernel_launch: bad inputs (n_in %d, ws %zu, need %zu)\n", n_in, ws_size, (size_t)WS_END); grid = -1; return; }
        int dev = 0, cus = 0, per_cu = 0;
        (void)hipGetDevice(&dev);
        (void)hipDeviceGetAttribute(&cus, hipDeviceAttributeMultiprocessorCount, dev);
        if (hipFuncSetAttribute((const void*)hymba_fwd, hipFuncAttributeMaxDynamicSharedMemorySize, LDS_BYTES) != hipSuccess) { fprintf(stderr, "kernel_launch: hipFuncSetAttribute failed\n"); grid = -1; return; }
        if (hipOccupancyMaxActiveBlocksPerMultiprocessor(&per_cu, (const void*)hymba_fwd, NTHREADS, LDS_BYTES) != hipSuccess || per_cu < 1) { fprintf(stderr, "kernel_launch: occupancy query says %d\n", per_cu); per_cu = 1; }
        (void)hipGetLastError();
        grid = cus * 1;
    }
    if (grid < 0) return;
    Args a{};
    for (int i = 0; i < 16; ++i) a.in[i] = (const float*)d_in[i];
    a.out = (float*)d_out; a.ws = (unsigned char*)d_ws;
#if N_LAUNCH_SPLIT
    for (int ph = 0; ph < 7; ++ph) { a.ph_lo = ph; a.ph_hi = ph + 1; hipLaunchKernelGGL(hymba_fwd, dim3(grid), dim3(NTHREADS), LDS_BYTES, stream, a); }
#else
    a.ph_lo = 0; a.ph_hi = 7;
    if (hipMemsetAsync((char*)d_ws + WS_BAR, 0, (size_t)XCD_BAR_WORDS * 4, stream) != hipSuccess) { fprintf(stderr, "kernel_launch: memset of the barrier words failed\n"); return; }
    void* args[] = {&a};
    hipError_t e = hipLaunchCooperativeKernel((const void*)hymba_fwd, dim3(grid), dim3(NTHREADS), args, LDS_BYTES, stream);
    if (e != hipSuccess) fprintf(stderr, "cooperative launch failed: %s (grid %d)\n", hipGetErrorString(e), grid);
#endif
}
```

```cpp
#include <hip/hip_runtime.h>
#include <hip/hip_cooperative_groups.h>
#include <cstdio>
namespace cg = cooperative_groups;

#ifndef REP_P0
#define REP_P0 1
#endif
#ifndef REP_P1
#define REP_P1 1
#endif
#ifndef REP_P2
#define REP_P2 1
#endif
#ifndef REP_ML
#define REP_ML 1
#endif
#ifndef REP_NSA
#define REP_NSA 1
#endif
#ifndef REP_P5
#define REP_P5 1
#endif
#ifndef N_LAUNCH_SPLIT
#define N_LAUNCH_SPLIT 0
#endif

#define LAS __attribute__((address_space(3)))
typedef unsigned short bf16_t;
typedef short bf16x8 __attribute__((ext_vector_type(8)));
typedef short bf16x4 __attribute__((ext_vector_type(4)));
typedef float f32x4 __attribute__((ext_vector_type(4)));
typedef unsigned u32x4 __attribute__((ext_vector_type(4)));
typedef unsigned u32x2 __attribute__((ext_vector_type(2)));

constexpr int NB = 4, T = 4096, D = 4096, MROWS = NB * T;
constexpr int NP = 15360;
constexpr int NWIN = 15424;
constexpr int W_IN_COLS = 15416;
constexpr int C_MQ = 0, C_MK = 1024, C_MV = 2048, C_MO = 4096, C_MZ = 6144, C_AQ = 8192, C_CK = 10240, C_CV = 10752,
              C_SK = 11264, C_SV = 11776, C_WK = 12288, C_WV = 12800, C_AZ = 13312;
constexpr int NTHREADS = 512;
constexpr int LDS_BYTES = 147456;

#define XCD_BAR_WORDS 3456
constexpr size_t WS_HB = 0;
constexpr size_t WS_WIN = WS_HB + (size_t)MROWS * D * 2;
constexpr size_t WS_WOUT = WS_WIN + (size_t)NWIN * D * 2;
constexpr size_t WS_PROJ = WS_WOUT + (size_t)D * D * 2;
constexpr size_t WS_GATES = WS_PROJ + (size_t)MROWS * NP * 2;
constexpr size_t WS_QKC = WS_GATES + (size_t)MROWS * 64 * 4;
constexpr size_t WS_SVT = WS_QKC + (size_t)MROWS * 2048 * 2;
constexpr size_t WS_WVT = WS_SVT + (size_t)16 * 128 * 4096 * 2;
constexpr size_t WS_KC = WS_WVT + (size_t)16 * 128 * 4096 * 2;
constexpr size_t WS_VCT = WS_KC + (size_t)16 * 256 * 128 * 2;
constexpr size_t WS_W1T = WS_VCT + (size_t)16 * 256 * 128 * 2;
constexpr size_t WS_W2T = WS_W1T + (size_t)2 * 128 * 4096 * 2;
constexpr size_t WS_PB = WS_W2T + (size_t)2 * 128 * 128 * 2;
constexpr size_t WS_HM = WS_PB + 1024;
constexpr size_t WS_SS = WS_HM + (size_t)MROWS * 2048 * 2;
constexpr size_t WS_SSQ = WS_SS + (size_t)MROWS * 128 * 4;
constexpr size_t WS_END = WS_SSQ + (size_t)MROWS * 64 * 4;
constexpr size_t WS_KT = WS_END;
constexpr size_t WS_END2 = WS_KT + (size_t)4 * 1024 * T * 2;
constexpr size_t WS_BAR = WS_END2 + 256;
constexpr size_t WS_END3 = WS_BAR + (size_t)XCD_BAR_WORDS * 4;
static_assert(WS_END3 <= ((size_t)1 << 30), "workspace map must fit 1 GiB");

struct Args { const float* in[16]; float* out; unsigned char* ws; int ph_lo, ph_hi; };

__device__ __forceinline__ unsigned pk_bf16(float lo, float hi) { unsigned r; asm("v_cvt_pk_bf16_f32 %0, %1, %2" : "=v"(r) : "v"(lo), "v"(hi)); return r; }
__device__ __forceinline__ bf16_t f2bf(float f) { return (bf16_t)(pk_bf16(f, 0.f) & 0xffffu); }
__device__ __forceinline__ float bf2f(unsigned b) { return __uint_as_float(b << 16); }
__device__ __forceinline__ float bflo(unsigned w) { return __uint_as_float(w << 16); }
__device__ __forceinline__ float bfhi(unsigned w) { return __uint_as_float(w & 0xffff0000u); }
__device__ __forceinline__ float wave_sum(float v) {
#pragma unroll
    for (int o = 32; o >= 1; o >>= 1) v += __shfl_xor(v, o);
    return v;
}
__device__ __forceinline__ float colgroup_max(float x) {
    const unsigned xi = __float_as_uint(x);
    const auto r = __builtin_amdgcn_permlane32_swap(xi, xi, false, false);
    const float m1 = fmaxf(__uint_as_float(r[0]), __uint_as_float(r[1]));
    const unsigned mi = __float_as_uint(m1);
    const auto r2 = __builtin_amdgcn_permlane16_swap(mi, mi, false, false);
    return fmaxf(__uint_as_float(r2[0]), __uint_as_float(r2[1]));
}
__device__ __forceinline__ float siluf(float x) { return x / (1.f + __expf(-x)); }
__device__ __forceinline__ float sigm(float x) { return 1.f / (1.f + __expf(-x)); }
__device__ __forceinline__ f32x4 mfma16(bf16x8 a, bf16x8 b, f32x4 c) { return __builtin_amdgcn_mfma_f32_16x16x32_bf16(a, b, c, 0, 0, 0); }
__device__ __forceinline__ bf16x8 as_bf16x8(u32x4 v) { union { u32x4 u; bf16x8 b; } x; x.u = v; return x.b; }

#define XB_TMO      128
#define XB_XCNT(j)  (256  + 64 * (j))
#define XB_XSUB(j)  (1280 + 64 * (j))
#define XB_XGEN(j)  (2304 + 64 * (j))
#define XB_TOP      3328
#define XB_TOPGEN   3392
#define XB_SPIN_CAP (1u << 18)
__device__ __forceinline__ unsigned xb_ld(unsigned* p)              { return __hip_atomic_load(p, __ATOMIC_RELAXED, __HIP_MEMORY_SCOPE_AGENT); }
__device__ __forceinline__ unsigned xb_add(unsigned* p, unsigned v) { return __hip_atomic_fetch_add(p, v, __ATOMIC_RELAXED, __HIP_MEMORY_SCOPE_AGENT); }
__device__ __forceinline__ unsigned xb_xcc_id() { return (unsigned)__builtin_amdgcn_s_getreg((3 << 11) | 20) & 0xFu; }
#define XB_SPIN(cond, bar) do { unsigned _sp = 0; while (cond) { __builtin_amdgcn_s_sleep(1); \
    if ((++_sp & 255u) == 0u) { if (xb_ld(&(bar)[XB_TMO])) break; if (_sp > XB_SPIN_CAP) { atomicAdd(&(bar)[XB_TMO], 1u); break; } } } } while (0)
struct XcdBarrier { unsigned* bar; unsigned x; volatile LAS unsigned* st; };
__device__ __forceinline__ XcdBarrier xcd_barrier_post(unsigned* bar, volatile LAS unsigned* st) {
    XcdBarrier b; b.bar = bar; b.x = xb_xcc_id(); b.st = st;
    if (threadIdx.x == 0) (void)xb_add(&bar[XB_XCNT(b.x)], 1u);
    return b;
}
__device__ __forceinline__ void xcd_barrier_complete(unsigned* bar, unsigned x, unsigned& nloc, unsigned& nx) {
    const unsigned G = gridDim.x * gridDim.y * gridDim.z;
    unsigned sum, cnt, mine, sp = 0u;
    for (;;) {
        sum = 0u; cnt = 0u; mine = 0u;
#pragma unroll
        for (unsigned j = 0; j < 16; ++j) { const unsigned c = xb_ld(&bar[XB_XCNT(j)]); sum += c; cnt += (c > 0u) ? 1u : 0u; mine = (j == x) ? c : mine; }
        if (sum == G) break;
        __builtin_amdgcn_s_sleep(1);
        if ((++sp & 255u) == 0u) { if (xb_ld(&bar[XB_TMO])) break; if (sp > XB_SPIN_CAP) { atomicAdd(&bar[XB_TMO], 1u); break; } }
    }
    nloc = mine > 0u ? mine : 1u; nx = cnt > 0u ? cnt : 1u;
}
__device__ __forceinline__ void xcd_barrier(const XcdBarrier& b) {
    asm volatile("s_waitcnt vmcnt(0)" ::: "memory");
    __syncthreads();
    if (threadIdx.x == 0) {
        unsigned* bar = b.bar;
        __builtin_amdgcn_s_waitcnt(0);
        unsigned nloc = b.st[0], nx = b.st[1];
        if (nloc == 0u) { xcd_barrier_complete(bar, b.x, nloc, nx); b.st[0] = nloc; b.st[1] = nx; }
        const unsigned old = xb_add(&bar[XB_XSUB(b.x)], 1u);
        const unsigned gen = old / nloc;
        if (old + 1u == (gen + 1u) * nloc) {
            __builtin_amdgcn_fence(__ATOMIC_RELEASE, "agent");
            asm volatile("s_waitcnt vmcnt(0)" ::: "memory");
            const unsigned og = xb_add(&bar[XB_TOP], 1u);
            const unsigned tg = og / nx;
            if (og + 1u == (tg + 1u) * nx) xb_add(&bar[XB_TOPGEN], 1u);
            else XB_SPIN(xb_ld(&bar[XB_TOPGEN]) == tg, bar);
            __builtin_amdgcn_fence(__ATOMIC_ACQUIRE, "agent");
            xb_add(&bar[XB_XGEN(b.x)], 1u);
            asm volatile("s_waitcnt vmcnt(0)" ::: "memory");
        } else {
            XB_SPIN(xb_ld(&bar[XB_XGEN(b.x)]) == gen, bar);
            __builtin_amdgcn_fence(__ATOMIC_ACQUIRE, "agent");
            asm volatile("s_waitcnt vmcnt(0)" ::: "memory");
        }
    }
    __syncthreads();
}

namespace pg8 {
constexpr int BM = 256, BK = 64, HALF = 128, HTB = HALF * BK * 2, STAGE_BYTES = 8 * HTB, NXCD = 8, WGM = 8;
__host__ __device__ __forceinline__ int lds_byte(int r, int c) { const int st = (r >> 4) * 2 + (c >> 5), rr = r & 15, cc = c & 31, ob = rr * 64 + cc * 2; return st * 1024 + (ob ^ (((ob >> 9) & 1) << 5)); }
__host__ __device__ __forceinline__ void stage_rc(int b, int& R, int& C) { const int st = b / 1024, sb = b % 1024, swz = sb ^ (((sb >> 9) & 1) << 5); R = (st >> 1) * 16 + swz / 64; C = (st & 1) * 32 + (swz % 64) / 2; }
__host__ __device__ __forceinline__ int perm32(int rho) { const int n = rho >> 4, i = rho & 15; return 8 * (i >> 2) + 4 * n + (i & 3); }
struct Unit { int pm, pn; };
struct Gemm { const bf16_t* A; const bf16_t* Bt; int M, N, K; };
struct StaticOrder {
    int nM, nN, nwg, G, c;
    __device__ void init(int M, int N, int G_, int c_) { nM = M / BM; nN = N / BM; nwg = nM * nN; G = G_; c = c_; }
    __device__ bool next(int i, Unit& u) const {
        const long L = (long)i * G + c; if (L >= nwg) return false;
        int wgid = (int)L; { const int q = nwg / NXCD, r = nwg % NXCD, xcd = wgid % NXCD, off = wgid / NXCD; wgid = (xcd < r ? xcd * (q + 1) : r * (q + 1) + (xcd - r) * q) + off; }
        const int nig = WGM * nN, gid = wgid / nig, fm = gid * WGM, gsz = (nM - fm) < WGM ? (nM - fm) : WGM;
        u.pm = fm + ((wgid % nig) % gsz); u.pn = (wgid % nig) / gsz; return true;
    }
};

template <class Epi, bool ALIGN_EPI = true, bool SP2 = true>
__device__ __forceinline__ void gemm_phase(LAS unsigned char* lds, const Gemm g, const StaticOrder& S, const Epi& E) {
    const int tid = threadIdx.x, wid = __builtin_amdgcn_readfirstlane(tid >> 6), lane = tid & 63, wr = wid >> 2, wc = wid & 3, fr = lane & 15, fq = lane >> 4;
    const int K = g.K, nt = K / BK;
    unsigned voffA[2], voffB[2];
#pragma unroll
    for (int i = 0; i < 2; ++i) { int R, C; stage_rc(tid * 16 + i * 8192, R, C); const int Rb = Epi::PERM ? ((R & ~31) + perm32(R & 31)) : R;
        voffA[i] = (unsigned)(R * K + C) * 2u; voffB[i] = (unsigned)(Rb * K + C) * 2u; }
    const size_t kstep = (size_t)(BK * 2);
    const size_t hstep = (size_t)HALF * K * 2;
    const size_t tstep = 2 * hstep;
    const unsigned ldsw = (unsigned)wid * 1024u;
    const int aoff = lds_byte(wr * 64 + fr, fq * 8), boff = lds_byte(wc * 32 + fr, fq * 8);
#define PG8_SA(b, h) (((b) * 2 + (h)) * HTB)
#define PG8_SB(b, h) ((4 + (b) * 2 + (h)) * HTB)
#define PG8_STAGE(bufoff, gbase, voff) do { _Pragma("unroll") for (int _i = 0; _i < 2; ++_i) \
        __builtin_amdgcn_global_load_lds((const unsigned*)((const char*)(gbase) + (voff)[_i]), (LAS unsigned*)(lds + (bufoff) + ldsw + _i * 8192), 16, 0, 0); } while (0)
#define PG8_LDA(dst, b, h) do { _Pragma("unroll") for (int m = 0; m < 4; ++m) _Pragma("unroll") for (int k = 0; k < 2; ++k) dst[m][k] = *(const LAS bf16x8*)(lds + PG8_SA(b, h) + aoff + m * 2048 + k * 1024); } while (0)
#define PG8_LDB(dst, b, h) do { _Pragma("unroll") for (int n = 0; n < 2; ++n) _Pragma("unroll") for (int k = 0; k < 2; ++k) dst[n][k] = *(const LAS bf16x8*)(lds + PG8_SB(b, h) + boff + n * 2048 + k * 1024); } while (0)
#define PG8_MMA(ai, bj, At, Bt) do { __builtin_amdgcn_s_setprio(1); _Pragma("unroll") for (int m = 0; m < 4; ++m) _Pragma("unroll") for (int n = 0; n < 2; ++n) _Pragma("unroll") for (int k = 0; k < 2; ++k) \
        acc[ai][bj][m][n] = __builtin_amdgcn_mfma_f32_16x16x32_bf16(Bt[n][k], At[m][k], acc[ai][bj][m][n], 0, 0, 0); __builtin_amdgcn_s_setprio(0); } while (0)
#define PG8_WAIT_V(n) asm volatile("s_waitcnt vmcnt(" #n ")" ::: "memory")
#define PG8_WAIT_L(n) asm volatile("s_waitcnt lgkmcnt(" #n ")" ::: "memory")
#define PG8_BAR __builtin_amdgcn_s_barrier()
#define PG8_SCHED __builtin_amdgcn_sched_barrier(0)
    Unit cur, nxt; int ui = 0;
    if (!S.next(0, cur)) return;
    f32x4 acc[2][2][4][2];
#pragma unroll
    for (int a = 0; a < 2; ++a)
#pragma unroll
        for (int b = 0; b < 2; ++b)
#pragma unroll
            for (int m = 0; m < 4; ++m)
#pragma unroll
                for (int n = 0; n < 2; ++n) acc[a][b][m][n] = (f32x4){0.f, 0.f, 0.f, 0.f};
    bf16x8 At[4][2], B0[2][2], B1[2][2];
    const char* cA = (const char*)g.A + (size_t)cur.pm * tstep; const char* cB = (const char*)g.Bt + (size_t)cur.pn * tstep;
    if constexpr (SP2) {
        PG8_STAGE(PG8_SB(0, 0), cB, voffB); PG8_STAGE(PG8_SB(0, 1), cB + hstep, voffB); PG8_STAGE(PG8_SA(0, 0), cA, voffA); PG8_STAGE(PG8_SA(0, 1), cA + hstep, voffA);
        if (wr == 1) PG8_BAR;
        PG8_WAIT_V(2); PG8_BAR;
        PG8_STAGE(PG8_SB(1, 0), cB + kstep, voffB); PG8_STAGE(PG8_SA(1, 0), cA + kstep, voffA); PG8_STAGE(PG8_SB(1, 1), cB + hstep + kstep, voffB);
        PG8_WAIT_V(6); PG8_BAR;
    } else {
    PG8_STAGE(PG8_SB(0, 0), cB, voffB); PG8_STAGE(PG8_SA(0, 0), cA, voffA); PG8_STAGE(PG8_SB(0, 1), cB + hstep, voffB); PG8_STAGE(PG8_SA(0, 1), cA + hstep, voffA);
    if (wr == 1) PG8_BAR;
    PG8_WAIT_V(4); PG8_BAR;
    PG8_STAGE(PG8_SB(1, 0), cB + kstep, voffB); PG8_STAGE(PG8_SA(1, 0), cA + kstep, voffA); PG8_STAGE(PG8_SB(1, 1), cB + hstep + kstep, voffB);
    PG8_WAIT_V(6); PG8_BAR;
    }
    for (;;) {
        const bool has_next = S.next(ui + 1, nxt);
        const char* nA = has_next ? (const char*)g.A + (size_t)nxt.pm * tstep : cA; const char* nB = has_next ? (const char*)g.Bt + (size_t)nxt.pn * tstep : cB;
        for (int t = 0; t < nt; t += 2) {
            const bool last = (t == nt - 2);
            const char* a1 = cA + (size_t)(t + 1) * kstep;
            const char* a2 = last ? nA : cA + (size_t)(t + 2) * kstep; const char* b2 = last ? nB : cB + (size_t)(t + 2) * kstep;
            const char* a3 = a2 + kstep; const char* b3 = b2 + kstep;
            if constexpr (SP2) {
            PG8_LDB(B0, 0, 0); PG8_LDB(B1, 0, 1); PG8_SCHED; PG8_LDA(At, 0, 0); PG8_STAGE(PG8_SA(1, 1), a1 + hstep, voffA);
            PG8_WAIT_V(8); PG8_WAIT_L(0); PG8_BAR; PG8_MMA(0, 0, At, B0); PG8_MMA(0, 1, At, B1); PG8_BAR; PG8_SCHED;
            PG8_LDA(At, 0, 1); PG8_STAGE(PG8_SB(0, 0), b2, voffB); PG8_STAGE(PG8_SB(0, 1), b2 + hstep, voffB); PG8_STAGE(PG8_SA(0, 0), a2, voffA);
            PG8_WAIT_V(8); PG8_WAIT_L(0); PG8_BAR; PG8_MMA(1, 0, At, B0); PG8_MMA(1, 1, At, B1); PG8_BAR; PG8_SCHED;
            PG8_LDB(B0, 1, 0); PG8_LDB(B1, 1, 1); PG8_SCHED; PG8_LDA(At, 1, 0); PG8_STAGE(PG8_SA(0, 1), a2 + hstep, voffA);
            PG8_WAIT_V(8); PG8_WAIT_L(0); PG8_BAR; PG8_MMA(0, 0, At, B0); PG8_MMA(0, 1, At, B1); PG8_BAR; PG8_SCHED;
            PG8_LDA(At, 1, 1); PG8_STAGE(PG8_SB(1, 0), b3, voffB); PG8_STAGE(PG8_SB(1, 1), b3 + hstep, voffB); PG8_STAGE(PG8_SA(1, 0), a3, voffA);
            PG8_WAIT_V(8); PG8_WAIT_L(0); PG8_BAR; PG8_MMA(1, 0, At, B0); PG8_MMA(1, 1, At, B1); PG8_BAR; PG8_SCHED;
            } else {
            PG8_LDB(B0, 0, 0); PG8_SCHED; PG8_LDA(At, 0, 0); PG8_STAGE(PG8_SA(1, 1), a1 + hstep, voffA);
            PG8_WAIT_L(8); PG8_BAR; PG8_WAIT_L(0); PG8_MMA(0, 0, At, B0); PG8_BAR; PG8_SCHED;
            PG8_LDB(B1, 0, 1); PG8_STAGE(PG8_SB(0, 0), b2, voffB);
            PG8_BAR; PG8_WAIT_L(0); PG8_MMA(0, 1, At, B1); PG8_BAR;
            PG8_LDA(At, 0, 1); PG8_STAGE(PG8_SA(0, 0), a2, voffA);
            PG8_BAR; PG8_WAIT_L(0); PG8_MMA(1, 0, At, B0); PG8_BAR; PG8_SCHED;
            PG8_STAGE(PG8_SB(0, 1), b2 + hstep, voffB);
            PG8_WAIT_V(6); PG8_BAR; PG8_MMA(1, 1, At, B1); PG8_BAR;
            PG8_LDB(B0, 1, 0); PG8_SCHED; PG8_LDA(At, 1, 0); PG8_STAGE(PG8_SA(0, 1), a2 + hstep, voffA);
            PG8_WAIT_L(8); PG8_BAR; PG8_WAIT_L(0); PG8_MMA(0, 0, At, B0); PG8_BAR; PG8_SCHED;
            PG8_LDB(B1, 1, 1); PG8_STAGE(PG8_SB(1, 0), b3, voffB);
            PG8_BAR; PG8_WAIT_L(0); PG8_MMA(0, 1, At, B1); PG8_BAR;
            PG8_LDA(At, 1, 1); PG8_STAGE(PG8_SA(1, 0), a3, voffA);
            PG8_BAR; PG8_WAIT_L(0); PG8_MMA(1, 0, At, B0); PG8_BAR; PG8_SCHED;
            PG8_STAGE(PG8_SB(1, 1), b3 + hstep, voffB);
            PG8_WAIT_V(6); PG8_BAR; PG8_MMA(1, 1, At, B1); PG8_BAR;
            }
        }
        if constexpr (ALIGN_EPI) { if (wr == 0) PG8_BAR; }
        E(acc, cur, wr, wc, fr, fq);
        if (!has_next) break;
#pragma unroll
        for (int a = 0; a < 2; ++a)
#pragma unroll
            for (int b = 0; b < 2; ++b)
#pragma unroll
                for (int m = 0; m < 4; ++m)
#pragma unroll
                    for (int n = 0; n < 2; ++n) acc[a][b][m][n] = (f32x4){0.f, 0.f, 0.f, 0.f};
        cur = nxt; cA = nA; cB = nB; ++ui;
        if constexpr (ALIGN_EPI) { if (wr == 1) PG8_BAR; }
    }
    PG8_WAIT_V(0);
    if constexpr (!ALIGN_EPI) { if (wr == 0) PG8_BAR; }
    PG8_BAR;
#undef PG8_SA
#undef PG8_SB
#undef PG8_STAGE
#undef PG8_LDA
#undef PG8_LDB
#undef PG8_MMA
#undef PG8_WAIT_V
#undef PG8_WAIT_L
#undef PG8_BAR
#undef PG8_SCHED
}

struct EpiProj {
    static constexpr bool PERM = true;
    bf16_t* O; int ldc;
    __device__ __forceinline__ void operator()(const f32x4 (&acc)[2][2][4][2], const Unit& u, int wr, int wc, int fr, int fq) const {
        const int row0 = u.pm * BM + wr * 64 + fr, col0 = u.pn * BM + wc * 32 + 8 * fq;
#pragma unroll
        for (int ai = 0; ai < 2; ++ai)
#pragma unroll
            for (int m = 0; m < 4; ++m) { bf16_t* rowp = O + (size_t)(row0 + ai * HALF + m * 16) * ldc + col0;
#pragma unroll
                for (int bj = 0; bj < 2; ++bj) { const f32x4 v0 = acc[ai][bj][m][0], v1 = acc[ai][bj][m][1];
                    u32x4 w; w.x = pk_bf16(v0[0], v0[1]); w.y = pk_bf16(v0[2], v0[3]); w.z = pk_bf16(v1[0], v1[1]); w.w = pk_bf16(v1[2], v1[3]);
                    *(u32x4*)(rowp + bj * HALF) = w; } }
    }
};
}

__device__ __forceinline__ int map_win(int n) {
    if (n < 8192) return n;
    if (n < 13312) return n + 8;
    if (n < 15360) return n + 56;
    if (n < 15368) return n - 15360 + 8192;
    if (n < 15416) return n - 15368 + 13320;
    return -1;
}
template <bool WIN>
__device__ void transpose_cvt(const float* __restrict__ src, int src_ld, bf16_t* __restrict__ dst, int K, int ntn) {
    const int tid = threadIdx.x, lane = tid & 63, n4 = (lane & 15) * 4, k8 = (lane >> 4) * 8;
    const int nkt = K / 32, total = ntn * nkt, gw = blockIdx.x * 8 + (tid >> 6), nw = gridDim.x * 8;
    for (int it = gw; it < total; it += nw) {
        const int tn = it / nkt, tk = it - tn * nkt, n = tn * 64 + n4;
        const int sc = WIN ? map_win(n) : n;
        f32x4 v[8];
#pragma unroll
        for (int j = 0; j < 8; ++j) v[j] = (sc >= 0) ? *(const f32x4*)(src + (size_t)(tk * 32 + k8 + j) * src_ld + sc) : (f32x4){0.f, 0.f, 0.f, 0.f};
#pragma unroll
        for (int c = 0; c < 4; ++c) { u32x4 w; w.x = pk_bf16(v[0][c], v[1][c]); w.y = pk_bf16(v[2][c], v[3][c]); w.z = pk_bf16(v[4][c], v[5][c]); w.w = pk_bf16(v[6][c], v[7][c]);
            *(u32x4*)(dst + (size_t)(n + c) * K + tk * 32 + k8) = w; }
    }
}

__device__ void phase0(const Args& a, LAS unsigned char* lds) {
    const int tid = threadIdx.x, lane = tid & 63;
    unsigned char* ws = a.ws;
    {
        const int gw = ((tid >> 6) == 0) ? (int)blockIdx.x : 256;
        if (gw < 256) { const int kv = gw >> 7, e = gw & 127; const float* pos = kv ? a.in[10] : a.in[7]; const float* w1 = kv ? a.in[11] : a.in[8];
            float sacc = 0.f;
#pragma unroll 8
            for (int k = lane; k < 4096; k += 64) sacc += pos[k] * w1[(size_t)k * 128 + e];
            sacc = wave_sum(sacc);
            if (lane == 0) ((float*)(ws + WS_PB))[gw] = sacc; }
    }
    {
        const float* x = a.in[0]; const float* gain = a.in[1]; bf16_t* HB = (bf16_t*)(ws + WS_HB);
        const int gw = blockIdx.x * 8 + (tid >> 6), nw = gridDim.x * 8;
        for (int row = gw; row < MROWS; row += nw) {
            const f32x4* xr = (const f32x4*)(x + (size_t)row * D);
            f32x4 v[16]; float ss = 0.f;
#pragma unroll
            for (int i = 0; i < 16; ++i) { v[i] = xr[lane + 64 * i]; ss += (v[i][0] * v[i][0] + v[i][1] * v[i][1]) + (v[i][2] * v[i][2] + v[i][3] * v[i][3]); }
            ss = wave_sum(ss);
            const float rstd = 1.0f / sqrtf(ss * (1.0f / D) + 1e-6f);
#pragma unroll
            for (int i = 0; i < 16; ++i) { const f32x4 g = ((const f32x4*)gain)[lane + 64 * i];
                u32x2 w; w.x = pk_bf16(v[i][0] * rstd * g[0], v[i][1] * rstd * g[1]); w.y = pk_bf16(v[i][2] * rstd * g[2], v[i][3] * rstd * g[3]);
                *(u32x2*)(HB + (size_t)row * D + (lane + 64 * i) * 4) = w; }
        }
    }
    transpose_cvt<true>(a.in[2], W_IN_COLS, (bf16_t*)(ws + WS_WIN), D, NWIN / 64);
    transpose_cvt<false>(a.in[14], D, (bf16_t*)(ws + WS_WOUT), D, D / 64);
    transpose_cvt<false>(a.in[8], 128, (bf16_t*)(ws + WS_W1T), 4096, 2);
    transpose_cvt<false>(a.in[11], 128, (bf16_t*)(ws + WS_W1T) + 128 * 4096, 4096, 2);
    transpose_cvt<false>(a.in[9], 128, (bf16_t*)(ws + WS_W2T), 128, 2);
    transpose_cvt<false>(a.in[12], 128, (bf16_t*)(ws + WS_W2T) + 128 * 128, 128, 2);
}

__device__ void gate_gemm(const Args& a, LAS unsigned char* lds) {
    const int tid = threadIdx.x, lane = tid & 63, l16 = lane & 15, g4 = lane >> 4, wv = tid >> 6;
    const bf16_t* HB = (const bf16_t*)(a.ws + WS_HB); const bf16_t* WG = (const bf16_t*)(a.ws + WS_WIN) + (size_t)NP * D;
    float* GATES = (float*)(a.ws + WS_GATES);
    LAS float* part = (LAS float*)lds;
    for (int rb = blockIdx.x; rb < MROWS / 64; rb += gridDim.x) {
        const bf16_t* Ap = HB + (size_t)(rb * 64 + l16) * D + wv * 512 + g4 * 8;
        const bf16_t* Bp = WG + (size_t)l16 * D + wv * 512 + g4 * 8;
        f32x4 acc[4][4];
#pragma unroll
        for (int mt = 0; mt < 4; ++mt)
#pragma unroll
            for (int nt = 0; nt < 4; ++nt) acc[mt][nt] = (f32x4){0.f, 0.f, 0.f, 0.f};
#pragma unroll 2
        for (int ks = 0; ks < 16; ++ks) {
            bf16x8 af[4], bfr[4];
#pragma unroll
            for (int mt = 0; mt < 4; ++mt) af[mt] = *(const bf16x8*)(Ap + (size_t)mt * 16 * D + ks * 32);
#pragma unroll
            for (int nt = 0; nt < 4; ++nt) bfr[nt] = *(const bf16x8*)(Bp + (size_t)nt * 16 * D + ks * 32);
#pragma unroll
            for (int mt = 0; mt < 4; ++mt)
#pragma unroll
                for (int nt = 0; nt < 4; ++nt) acc[mt][nt] = mfma16(af[mt], bfr[nt], acc[mt][nt]);
        }
#pragma unroll
        for (int mt = 0; mt < 4; ++mt)
#pragma unroll
            for (int nt = 0; nt < 4; ++nt)
#pragma unroll
                for (int r = 0; r < 4; ++r) part[(wv * 64 + 16 * mt + 4 * g4 + r) * 68 + 16 * nt + l16] = acc[mt][nt][r];
        __syncthreads();
#pragma unroll
        for (int i = 0; i < 8; ++i) { const int idx = tid + 512 * i, row = idx >> 6, col = idx & 63; float sum = 0.f;
#pragma unroll
            for (int w8 = 0; w8 < 8; ++w8) sum += part[(w8 * 64 + row) * 68 + col];
            GATES[(size_t)(rb * 64 + row) * 64 + col] = sum; }
        __syncthreads();
    }
}

__device__ void phase2(const Args& a, LAS unsigned char* lds) {
    const int tid = threadIdx.x, lane = tid & 63, wv = tid >> 6, l16 = lane & 15, g4 = lane >> 4;
    unsigned char* ws = a.ws;
    const bf16_t* PROJ = (const bf16_t*)(ws + WS_PROJ);
    {
        const float* wconv = a.in[3]; bf16_t* QKC = (bf16_t*)(ws + WS_QKC); bf16_t* KT = (bf16_t*)(ws + WS_KT);
        LAS bf16_t* tl = (LAS bf16_t*)lds;
        for (int idx = blockIdx.x; idx < 4096; idx += gridDim.x) {
            const int cb = (idx + (idx >> 8)) & 15, rb = idx >> 4, row0 = rb * 64, t = tid >> 3, c16 = (tid & 7) * 16, ch = cb * 128 + c16;
            const int tin = (row0 & (T - 1)) + t;
            const bf16_t* src = PROJ + (size_t)(row0 + t) * NP + ch;
            float y[16];
#pragma unroll
            for (int e = 0; e < 16; ++e) y[e] = 0.f;
#pragma unroll
            for (int j = 0; j < 4; ++j) {
                if (tin - 3 + j >= 0) {
                    const u32x4 ua = *(const u32x4*)(src - (size_t)(3 - j) * NP), ub = *(const u32x4*)(src - (size_t)(3 - j) * NP + 8);
                    const float* wp = wconv + j * 2048 + ch;
                    const f32x4 w0 = *(const f32x4*)wp, w1 = *(const f32x4*)(wp + 4), w2 = *(const f32x4*)(wp + 8), w3 = *(const f32x4*)(wp + 12);
                    y[0] += w0[0] * bflo(ua[0]); y[1] += w0[1] * bfhi(ua[0]); y[2] += w0[2] * bflo(ua[1]); y[3] += w0[3] * bfhi(ua[1]);
                    y[4] += w1[0] * bflo(ua[2]); y[5] += w1[1] * bfhi(ua[2]); y[6] += w1[2] * bflo(ua[3]); y[7] += w1[3] * bfhi(ua[3]);
                    y[8] += w2[0] * bflo(ub[0]); y[9] += w2[1] * bfhi(ub[0]); y[10] += w2[2] * bflo(ub[1]); y[11] += w2[3] * bfhi(ub[1]);
                    y[12] += w3[0] * bflo(ub[2]); y[13] += w3[1] * bfhi(ub[2]); y[14] += w3[2] * bflo(ub[3]); y[15] += w3[3] * bfhi(ub[3]);
                }
            }
            const float osc = (cb >= 8) ? 0.0625f : 1.0f;
#pragma unroll
            for (int e = 0; e < 16; ++e) y[e] = siluf(y[e]) * osc;
            u32x4 o0, o1; o0.x = pk_bf16(y[0], y[1]); o0.y = pk_bf16(y[2], y[3]); o0.z = pk_bf16(y[4], y[5]); o0.w = pk_bf16(y[6], y[7]);
            o1.x = pk_bf16(y[8], y[9]); o1.y = pk_bf16(y[10], y[11]); o1.z = pk_bf16(y[12], y[13]); o1.w = pk_bf16(y[14], y[15]);
            bf16_t* dq = QKC + (size_t)(row0 + t) * 2048 + ch;
            *(u32x4*)dq = o0; *(u32x4*)(dq + 8) = o1;
            if (cb >= 8) {
                *(LAS u32x4*)(tl + t * 136 + c16) = o0; *(LAS u32x4*)(tl + t * 136 + c16 + 8) = o1;
                __syncthreads();
                const int d = tid >> 2, t16 = (tid & 3) * 16; unsigned e[16];
#pragma unroll
                for (int j = 0; j < 16; ++j) e[j] = tl[(t16 + j) * 136 + d];
                u32x4 w0, w1; w0.x = e[0] | (e[1] << 16); w0.y = e[2] | (e[3] << 16); w0.z = e[4] | (e[5] << 16); w0.w = e[6] | (e[7] << 16);
                w1.x = e[8] | (e[9] << 16); w1.y = e[10] | (e[11] << 16); w1.z = e[12] | (e[13] << 16); w1.w = e[14] | (e[15] << 16);
                bf16_t* dst = KT + ((size_t)(row0 >> 12) * 1024 + (cb - 8) * 128 + d) * T + (row0 & (T - 1)) + t16;
                *(u32x4*)dst = w0; *(u32x4*)(dst + 8) = w1;
                __syncthreads();
            }
        }
    }
    {
        LAS bf16_t* tl = (LAS bf16_t*)lds;
        for (int idx = blockIdx.x; idx < 2048; idx += gridDim.x) {
            const bf16_t* src; bf16_t* dst;
            if (idx < 2048) { const int which = idx >> 10, bg = (idx >> 6) & 15, tt = idx & 63, b = bg >> 2, g = bg & 3;
                src = PROJ + (size_t)(b * T + tt * 64) * NP + (which ? C_WV : C_SV) + g * 128;
                dst = (bf16_t*)(ws + (which ? WS_WVT : WS_SVT)) + (size_t)bg * 128 * T + tt * 64; }
#pragma unroll
            for (int i = 0; i < 2; ++i) { const int p = tid + 512 * i, t = p >> 4, d8 = (p & 15) * 8;
                *(LAS u32x4*)(tl + t * 136 + d8) = *(const u32x4*)(src + (size_t)t * NP + d8); }
            __syncthreads();
            { const int d = tid >> 2, t16 = (tid & 3) * 16; unsigned e[16];
#pragma unroll
              for (int j = 0; j < 16; ++j) e[j] = tl[(t16 + j) * 136 + d];
              u32x4 w0, w1; w0.x = e[0] | (e[1] << 16); w0.y = e[2] | (e[3] << 16); w0.z = e[4] | (e[5] << 16); w0.w = e[6] | (e[7] << 16);
              w1.x = e[8] | (e[9] << 16); w1.y = e[10] | (e[11] << 16); w1.z = e[12] | (e[13] << 16); w1.w = e[14] | (e[15] << 16);
              *(u32x4*)(dst + (size_t)d * T + t16) = w0; *(u32x4*)(dst + (size_t)d * T + t16 + 8) = w1; }
            __syncthreads();
        }
    }
    {
        LAS bf16_t* hid = (LAS bf16_t*)lds;
        LAS float* part = (LAS float*)(lds + 8192);
        const float* PB = (const float*)(ws + WS_PB);
        bf16_t* KC = (bf16_t*)(ws + WS_KC); bf16_t* VCT = (bf16_t*)(ws + WS_VCT);
        for (int item = blockIdx.x; item < 512; item += gridDim.x) {
            const int kv = item >> 8, bg = (item >> 4) & 15, ng = item & 15, b = bg >> 2, g = bg & 3;
            const bf16_t* W1 = (const bf16_t*)(ws + WS_W1T) + (size_t)kv * 128 * 4096; const bf16_t* W2 = (const bf16_t*)(ws + WS_W2T) + kv * 128 * 128;
            int n = ng * 16 + l16; if (n > 254) n = 254;
            const bf16_t* Ap = PROJ + (size_t)(b * T + 16 * n + 4 * wv) * NP + (kv ? C_CV : C_CK) + g * 128 + g4 * 8;
            const bf16_t* Bp = W1 + (size_t)l16 * 4096 + (4 * wv) * 128 + g4 * 8;
            f32x4 acc8[8];
#pragma unroll
            for (int et = 0; et < 8; ++et) acc8[et] = (f32x4){0.f, 0.f, 0.f, 0.f};
#pragma unroll 2
            for (int li = 0; li < 4; ++li)
#pragma unroll
                for (int dq = 0; dq < 4; ++dq) { const bf16x8 av = *(const bf16x8*)(Ap + (size_t)li * NP + dq * 32);
#pragma unroll
                    for (int et = 0; et < 8; ++et) acc8[et] = mfma16(av, *(const bf16x8*)(Bp + (size_t)et * 16 * 4096 + li * 128 + dq * 32), acc8[et]); }
#pragma unroll
            for (int et = 0; et < 8; ++et)
#pragma unroll
                for (int r = 0; r < 4; ++r) part[(wv * 16 + 4 * g4 + r) * 132 + 16 * et + l16] = acc8[et][r];
            __syncthreads();
            {
#pragma unroll
                for (int i = 0; i < 4; ++i) { const int idx = tid + 512 * i, row = idx >> 7, e = idx & 127; float sum = 0.f;
#pragma unroll
                    for (int w8 = 0; w8 < 8; ++w8) sum += part[(w8 * 16 + row) * 132 + e];
                    hid[row * 136 + e] = f2bf(siluf(sum + PB[kv * 128 + e])); }
            }
            __syncthreads();
            f32x4 acc2 = (f32x4){0.f, 0.f, 0.f, 0.f};
#pragma unroll
            for (int ks = 0; ks < 4; ++ks) acc2 = mfma16(*(const LAS bf16x8*)(hid + l16 * 136 + ks * 32 + g4 * 8), *(const bf16x8*)(W2 + (16 * wv + l16) * 128 + ks * 32 + g4 * 8), acc2);
            const int f = 16 * wv + l16, nb = ng * 16 + 4 * g4;
            float o[4];
#pragma unroll
            for (int r = 0; r < 4; ++r) o[r] = (nb + r < 255) ? acc2[r] : 0.f;
            if (kv == 0) {
#pragma unroll
                for (int r = 0; r < 4; ++r) KC[((size_t)bg * 256 + nb + r) * 128 + f] = f2bf(o[r]);
            } else { u32x2 w; w.x = pk_bf16(o[0], o[1]); w.y = pk_bf16(o[2], o[3]); *(u32x2*)(VCT + ((size_t)bg * 128 + f) * 256 + nb) = w; }
            __syncthreads();
        }
    }
}

__device__ __forceinline__ void mlstm_item(const Args& a, LAS unsigned char* lds, int item) {
    const int tid = threadIdx.x, lane = tid & 63, w = __builtin_amdgcn_readfirstlane(tid >> 6), l16 = lane & 15, g4 = lane >> 4;
    const int bh = item >> 4, sl = item & 15, b = bh >> 2, h = bh & 3;
    unsigned char* ws = a.ws;
    const bf16_t* PROJ = (const bf16_t*)(ws + WS_PROJ); const bf16_t* QKC = (const bf16_t*)(ws + WS_QKC); const float* GATES = (const float*)(ws + WS_GATES);
    bf16_t* HM = (bf16_t*)(ws + WS_HM); float* SS = (float*)(ws + WS_SS);
    LAS bf16_t* qs = (LAS bf16_t*)lds;
    LAS bf16_t* ks = qs + 64 * 264;
    LAS bf16_t* kT = ks + 64 * 264;
    LAS bf16_t* vT = kT + 256 * 72;
    LAS bf16_t* vTw = vT + 48 * 72;
    LAS bf16_t* CT = vTw + 48 * 72;
    LAS float* sc = (LAS float*)(CT + 48 * 264);
    LAS bf16_t* Pm = ks;
    for (int i = tid; i < 48 * 264; i += NTHREADS) CT[i] = 0;
    for (int i = tid; i < 16 * 72; i += NTHREADS) { const int r = i / 72; vT[(32 + r) * 72 + (i - r * 72)] = (r == 0) ? (bf16_t)0x3F80 : (bf16_t)0; vTw[(32 + r) * 72 + (i - r * 72)] = 0; }
    f32x4 Cacc[2][3];
#pragma unroll
    for (int i = 0; i < 2; ++i)
#pragma unroll
        for (int j = 0; j < 3; ++j) Cacc[i][j] = (f32x4){0.f, 0.f, 0.f, 0.f};
    float m_st = 0.f;
    const float bi = a.in[4][h], bfg = a.in[5][h];
    u32x4 qreg[4], kreg[4], ktreg[4], vreg; float gi = 0.f, gf = 0.f;
    const bf16_t* KT = (const bf16_t*)(ws + WS_KT) + ((size_t)b * 1024 + h * 256) * T;
    vreg = (u32x4){0, 0, 0, 0};
    const size_t rowbase = (size_t)b * T;
#define ML_PREFETCH(t0_) do { \
        _Pragma("unroll") for (int i = 0; i < 4; ++i) { const int p = tid + 512 * i, l = p >> 5, c8 = (p & 31) * 8; const bf16_t* s_ = QKC + (rowbase + (t0_) + l) * 2048 + h * 256 + c8; \
            qreg[i] = *(const u32x4*)s_; kreg[i] = *(const u32x4*)(s_ + 1024); \
            ktreg[i] = *(const u32x4*)(KT + (size_t)(p >> 3) * T + (t0_) + (p & 7) * 8); } \
        if (tid < 256) { const int l = tid >> 2, c8 = (tid & 3) * 8; vreg = *(const u32x4*)(PROJ + (rowbase + (t0_) + l) * NP + C_MV + h * 512 + sl * 32 + c8); } \
        if (tid < 64) { const float* gp = GATES + (rowbase + (t0_) + tid) * 64; gi = gp[h] + bi; gf = gp[4 + h] + bfg; } } while (0)
    ML_PREFETCH(0);
    __syncthreads();
    for (int c = 0; c < 64; ++c) {
        const int t0 = c * 64;
#pragma unroll
        for (int i = 0; i < 4; ++i) { const int p = tid + 512 * i, l = p >> 5, c8 = (p & 31) * 8;
            *(LAS u32x4*)(qs + l * 264 + c8) = qreg[i]; *(LAS u32x4*)(ks + l * 264 + c8) = kreg[i];
            *(LAS u32x4*)(kT + (p >> 3) * 72 + (p & 7) * 8) = ktreg[i]; }
        if (tid < 256) { const int l = tid >> 2, c8 = (tid & 3) * 8;
#pragma unroll
            for (int j = 0; j < 4; ++j) { vT[(c8 + 2 * j) * 72 + l] = (bf16_t)(vreg[j] & 0xffffu); vT[(c8 + 2 * j + 1) * 72 + l] = (bf16_t)(vreg[j] >> 16); } }
        if (w == 0) {
            const float lf = fminf(gf, 0.f) - log1pf(__expf(-fabsf(gf)));
            float bc = lf;
#pragma unroll
            for (int o = 1; o < 64; o <<= 1) { const float t = __shfl_up(bc, o); if (lane >= o) bc += t; }
            const float av = gi - bc; float pm = av;
#pragma unroll
            for (int o = 1; o < 64; o <<= 1) { const float t = __shfl_up(pm, o); if (lane >= o) pm = fmaxf(pm, t); }
            const float gtot = __shfl(bc, 63);
            const float mrow = fmaxf(m_st, pm), mr63 = __shfl(mrow, 63);
            sc[lane] = av; sc[64 + lane] = mrow; sc[128 + lane] = __expf(m_st - mrow); sc[192 + lane] = __expf(-(bc + mrow)); sc[256 + lane] = __expf(av - mr63);
            if (lane == 0) sc[320] = __expf(m_st - mr63);
            m_st = gtot + mr63;
        }
        if (c + 1 < 64) ML_PREFETCH(t0 + 64);
        __syncthreads();
        const int mt = w & 3, nq = w >> 2;
        unsigned ogr[4];
#pragma unroll
        for (int r = 0; r < 4; ++r) ogr[r] = PROJ[(rowbase + t0 + 16 * mt + 4 * g4 + r) * NP + C_MO + h * 512 + sl * 32 + 16 * nq + l16];
        f32x4 s0 = (f32x4){0.f, 0.f, 0.f, 0.f}, s1 = s0, ci0 = s0, ci2 = s0;
        {
            const LAS bf16_t* ap = qs + (16 * mt + l16) * 264 + g4 * 8;
            const LAS bf16_t* b0p = ks + (16 * (2 * nq) + l16) * 264 + g4 * 8;
            const LAS bf16_t* b1p = b0p + 16 * 264;
            const LAS bf16_t* c0p = CT + (16 * nq + l16) * 264 + g4 * 8;
            const LAS bf16_t* c2p = CT + (32 + l16) * 264 + g4 * 8;
            const bool do0 = (2 * nq <= mt), do1 = (2 * nq + 1 <= mt);
#pragma unroll
            for (int kq = 0; kq < 8; ++kq) {
                const bf16x8 av = *(const LAS bf16x8*)(ap + kq * 32);
                if (do0) s0 = mfma16(av, *(const LAS bf16x8*)(b0p + kq * 32), s0);
                if (do1) s1 = mfma16(av, *(const LAS bf16x8*)(b1p + kq * 32), s1);
                ci0 = mfma16(av, *(const LAS bf16x8*)(c0p + kq * 32), ci0);
                ci2 = mfma16(av, *(const LAS bf16x8*)(c2p + kq * 32), ci2);
            }
        }
        __syncthreads();
        {
#pragma unroll
            for (int r = 0; r < 4; ++r) { const int l = 16 * mt + 4 * g4 + r; const float mr = sc[64 + l];
                { const int s = 16 * (2 * nq) + l16; const float pv = (s <= l) ? s0[r] * __expf(sc[s] - mr) : 0.f; Pm[l * 72 + s] = f2bf(pv); }
                { const int s = 16 * (2 * nq + 1) + l16; const float pv = (s <= l) ? s1[r] * __expf(sc[s] - mr) : 0.f; Pm[l * 72 + s] = f2bf(pv); } }
#pragma unroll
            for (int i = 0; i < 5; ++i) { const int idx = tid + 512 * i; if (idx < 33 * 64) { const int row = idx >> 6, s = idx & 63; const float wt = sc[256 + s];
                vTw[row * 72 + s] = f2bf(row < 32 ? bf2f(vT[row * 72 + s]) * wt : wt); } }
        }
        __syncthreads();
        {
            f32x4 n0 = (f32x4){0.f, 0.f, 0.f, 0.f}, n2 = n0;
#pragma unroll
            for (int kq = 0; kq < 2; ++kq) { const bf16x8 av = *(const LAS bf16x8*)(Pm + (16 * mt + l16) * 72 + kq * 32 + g4 * 8);
                n0 = mfma16(av, *(const LAS bf16x8*)(vT + (16 * nq + l16) * 72 + kq * 32 + g4 * 8), n0);
                n2 = mfma16(av, *(const LAS bf16x8*)(vT + (32 + l16) * 72 + kq * 32 + g4 * 8), n2); }
            const int col = h * 512 + sl * 32 + 16 * nq + l16;
#pragma unroll
            for (int r = 0; r < 4; ++r) { const int l = 16 * mt + 4 * g4 + r; const float il = sc[128 + l];
                const float num = n0[r] + il * ci0[r]; float qn = n2[r] + il * ci2[r]; qn = __shfl(qn, lane & 48);
                const float den = fmaxf(fabsf(qn), sc[192 + l]);
                const size_t row = rowbase + t0 + l;
                const float og = sigm(bf2f(ogr[r]));
                const bf16_t hb = f2bf(og * num / den); HM[row * 2048 + col] = hb;
                float sq = bf2f(hb); sq *= sq;
                sq += __shfl_xor(sq, 1); sq += __shfl_xor(sq, 2); sq += __shfl_xor(sq, 4); sq += __shfl_xor(sq, 8);
                if (l16 == 0) SS[(row * 4 + h) * 32 + sl * 2 + nq] = sq; }
            const float keep = sc[320];
#pragma unroll
            for (int m2 = 0; m2 < 2; ++m2) {
#pragma unroll
                for (int j = 0; j < 3; ++j) Cacc[m2][j] *= keep;
#pragma unroll
                for (int kq = 0; kq < 2; ++kq) { const bf16x8 av = *(const LAS bf16x8*)(kT + (32 * w + 16 * m2 + l16) * 72 + kq * 32 + g4 * 8);
#pragma unroll
                    for (int j = 0; j < 3; ++j) Cacc[m2][j] = mfma16(av, *(const LAS bf16x8*)(vTw + (16 * j + l16) * 72 + kq * 32 + g4 * 8), Cacc[m2][j]); }
#pragma unroll
                for (int j = 0; j < 3; ++j) { u32x2 wv2; wv2.x = pk_bf16(Cacc[m2][j][0], Cacc[m2][j][1]); wv2.y = pk_bf16(Cacc[m2][j][2], Cacc[m2][j][3]);
                    *(LAS u32x2*)(CT + (16 * j + l16) * 264 + 32 * w + 16 * m2 + 4 * g4) = wv2; }
            }
        }
        __syncthreads();
    }
#undef ML_PREFETCH
}

struct TileDesc { const bf16_t* K; size_t kstr; const bf16_t* V; size_t vstr; int kp0, kstep, wlim, selj; };

constexpr float NEGL = -1e30f;
constexpr float QK_SC = 0.08838834764831845f * 1.4426950408889634f;

constexpr int TBN = 1088;
template <int MODE, int NTS>
__device__ __forceinline__ void nsa_tile(const LAS bf16_t* Kt, const LAS bf16_t* Vt, const LAS float* TB, const TileDesc& td, const bf16x8 (&qf)[2][4],
                                         const int (&tq)[2], const LAS unsigned long long* selm, int hh, int l16, int g4,
                                         f32x4 (&O)[8][2], float (&mrun)[2], float (&lrun)[2], const float (&invl)[2],
                                         LAS float* PA, LAS float* PBv, int w, int kt64, int t0, const bool MASKED) {
    const bool far = (t0 - (td.kp0 + 63 * td.kstep)) >= 790;
    const float bfar = TB[(1023 + 64) * 4 + hh];
    const bool alw0 = (td.selj < 0) || ((selm[0] >> td.selj) & 1ull), alw1 = (td.selj < 0) || ((selm[4] >> td.selj) & 1ull);
    constexpr bool any0 = (NTS & 1) != 0, any1 = (NTS & 2) != 0;
#pragma unroll 1
    for (int i = 0; i < 2; ++i) {
        f32x4 S[2][2];
#pragma unroll
        for (int mm = 0; mm < 2; ++mm) { S[mm][0] = (f32x4){0.f, 0.f, 0.f, 0.f}; S[mm][1] = S[mm][0]; }
#pragma unroll
        for (int mm = 0; mm < 2; ++mm)
#pragma unroll
            for (int kq = 0; kq < 4; ++kq) { const bf16x8 av = *(const LAS bf16x8*)(Kt + (32 * i + 16 * mm + l16) * 136 + kq * 32 + g4 * 8);
                if (any0) S[mm][0] = mfma16(av, qf[0][kq], S[mm][0]);
                if (any1) S[mm][1] = mfma16(av, qf[1][kq], S[mm][1]); }
#pragma unroll
        for (int nt = 0; nt < 2; ++nt) {
            const bool allowed = nt ? alw1 : alw0;
            if (!(nt ? any1 : any0)) continue;
            float mx = NEGL;
            if (MASKED) {
#pragma unroll
                for (int mm = 0; mm < 2; ++mm)
#pragma unroll
                    for (int r = 0; r < 4; ++r) {
                        const int kk = 32 * i + 16 * mm + 4 * g4 + r, dist = tq[nt] - (td.kp0 + td.kstep * kk);
                        const bool ok = allowed && dist >= 0 && dist < td.wlim;
                        float bias = bfar;
                        if (!far) { int di = dist < -64 ? -64 : dist; di = di > 1023 ? 1023 : di; bias = TB[(di + 64) * 4 + hh]; }
                        const float lg = ok ? S[mm][nt][r] * QK_SC + bias : NEGL;
                        S[mm][nt][r] = lg; mx = fmaxf(mx, lg);
                    }
            } else {
                if (far) {
#pragma unroll
                    for (int mm = 0; mm < 2; ++mm)
#pragma unroll
                        for (int r = 0; r < 4; ++r) { const float lg = S[mm][nt][r] * QK_SC + bfar; S[mm][nt][r] = lg; mx = fmaxf(mx, lg); }
                } else {
                    const LAS float* tp = TB + ((tq[nt] - td.kp0 - 4 * g4 + 64 - 32 * i - 19) * 4 + hh);
#pragma unroll
                    for (int mm = 0; mm < 2; ++mm)
#pragma unroll
                        for (int r = 0; r < 4; ++r) { const float lg = S[mm][nt][r] * QK_SC + tp[(19 - 16 * mm - r) * 4]; S[mm][nt][r] = lg; mx = fmaxf(mx, lg); }
                }
                if (!allowed) mx = NEGL;
            }
            if (MODE != 1) {
                mx = colgroup_max(mx);
                const float mnew = fmaxf(mrun[nt], mx), alpha = __builtin_amdgcn_exp2f(mrun[nt] - mnew);
                mrun[nt] = mnew; float ps = 0.f;
#pragma unroll
                for (int mm = 0; mm < 2; ++mm)
#pragma unroll
                    for (int r = 0; r < 4; ++r) { const float lg = S[mm][nt][r];
                        const float p = MASKED ? ((lg <= -1e29f) ? 0.f : __builtin_amdgcn_exp2f(lg - mnew)) : (allowed ? __builtin_amdgcn_exp2f(lg - mnew) : 0.f);
                        S[mm][nt][r] = p; ps += p; }
                lrun[nt] = lrun[nt] * alpha + ps;
                if (MODE == 2) {
                    if (__builtin_amdgcn_ballot_w64(alpha != 1.0f) != 0ull) {
#pragma unroll
                        for (int dt = 0; dt < 8; ++dt) O[dt][nt] *= alpha;
                    }
                }
            } else {
                const float mfix = mrun[nt], il = invl[nt];
#pragma unroll
                for (int mm = 0; mm < 2; ++mm) {
#pragma unroll
                    for (int r = 0; r < 4; ++r) { const float lg = S[mm][nt][r]; S[mm][nt][r] = (lg <= -1e29f) ? 0.f : __builtin_amdgcn_exp2f(lg - mfix) * il; }
                    float pa = (S[mm][nt][0] + S[mm][nt][1]) + (S[mm][nt][2] + 0.5f * S[mm][nt][3]), pb = 0.5f * S[mm][nt][3];
                    pa += __shfl_xor(pa, 1); pa += __shfl_xor(pa, 2); pb += __shfl_xor(pb, 1); pb += __shfl_xor(pb, 2);
                    if ((l16 & 3) == 0) { const int tok = 8 * w + 4 * nt + (l16 >> 2), j = 16 * kt64 + 4 * (2 * i + mm) + g4; PA[tok * 65 + j] = pa; if (j + 1 < 64) PBv[tok * 65 + j + 1] = pb; }
                }
            }
        }
        if (MODE != 0) {
            bf16x8 pb[2];
#pragma unroll
            for (int nt = 0; nt < 2; ++nt) { u32x4 u; u.x = pk_bf16(S[0][nt][0], S[0][nt][1]); u.y = pk_bf16(S[0][nt][2], S[0][nt][3]);
                u.z = pk_bf16(S[1][nt][0], S[1][nt][1]); u.w = pk_bf16(S[1][nt][2], S[1][nt][3]); pb[nt] = as_bf16x8(u); }
#pragma unroll
            for (int dt = 0; dt < 8; ++dt) { const LAS bf16_t* vp = Vt + (16 * dt + l16) * 72 + 32 * i + 4 * g4;
                const u32x2 lo = *(const LAS u32x2*)vp, hi = *(const LAS u32x2*)(vp + 16);
                const bf16x8 av = as_bf16x8((u32x4){lo.x, lo.y, hi.x, hi.y});
                if (any0) O[dt][0] = mfma16(av, pb[0], O[dt][0]);
                if (any1) O[dt][1] = mfma16(av, pb[1], O[dt][1]); }
        }
    }
}

__device__ __forceinline__ void nsa_load(const TileDesc& td, int tid, u32x4 (&kr)[2], u32x4 (&vr)[2]) {
#pragma unroll
    for (int i = 0; i < 2; ++i) { const int p = tid + 512 * i;
        kr[i] = *(const u32x4*)(td.K + (size_t)(p >> 4) * td.kstr + (p & 15) * 8);
        vr[i] = *(const u32x4*)(td.V + (size_t)(p >> 3) * td.vstr + (p & 7) * 8); }
}
__device__ __forceinline__ void nsa_store(LAS bf16_t* Kb, LAS bf16_t* Vb, int tid, const u32x4 (&kr)[2], const u32x4 (&vr)[2]) {
#pragma unroll
    for (int i = 0; i < 2; ++i) { const int p = tid + 512 * i;
        *(LAS u32x4*)(Kb + (p >> 4) * 136 + (p & 15) * 8) = kr[i];
        *(LAS u32x4*)(Vb + (p >> 3) * 72 + (p & 7) * 8) = vr[i]; }
}

__device__ __forceinline__ void nsa_unit(const Args& a, LAS unsigned char* lds, int bg, int qb) {
    const int tid = threadIdx.x, lane = tid & 63, w = __builtin_amdgcn_readfirstlane(tid >> 6), l16 = lane & 15, g4 = lane >> 4;
    const int b = bg >> 2, g = bg & 3, t0 = qb * 64, hh = l16 & 3;
    unsigned char* ws = a.ws;
    const bf16_t* PROJ = (const bf16_t*)(ws + WS_PROJ); const float* GATES = (const float*)(ws + WS_GATES);
    LAS bf16_t* Kb0 = (LAS bf16_t*)lds;
    LAS bf16_t* Vb0 = Kb0 + 2 * 64 * 136;
    LAS float* TB = (LAS float*)(Vb0 + 2 * 128 * 72);
    LAS float* PA = TB + 4 * TBN;
    LAS float* PBv = PA + 64 * 65;
    LAS unsigned long long* SELM = (LAS unsigned long long*)(PBv + 64 * 65);
    LAS unsigned long long* UNI = SELM + 64;
    {
        const float* rel = a.in[13];
        for (int i = tid; i < 4 * TBN; i += NTHREADS) { const int h = i & 3, d = (i >> 2) - 64; int bk = d < 0 ? 0 : d;
            if (d >= 16) { bk = 16 + (d >= 21) + (d >= 27) + (d >= 35) + (d >= 46) + (d >= 59) + (d >= 77) + (d >= 99) + (d >= 128) + (d >= 166) + (d >= 216) + (d >= 280) + (d >= 363) + (d >= 470) + (d >= 609) + (d >= 790); }
            TB[i] = rel[bk * 16 + g * 4 + h] * 1.4426950408889634f; }
        for (int i = tid; i < 2 * 64 * 65; i += NTHREADS) PA[i] = 0.f;
    }
    int tq[2]; bf16x8 qf[2][4];
#pragma unroll
    for (int nt = 0; nt < 2; ++nt) { tq[nt] = t0 + 8 * w + 4 * nt + (l16 >> 2); const size_t row = (size_t)b * T + tq[nt];
        const bf16_t* qp = PROJ + row * NP + C_AQ + (g * 4 + hh) * 128 + g4 * 8;
#pragma unroll
        for (int kq = 0; kq < 4; ++kq) qf[nt][kq] = *(const bf16x8*)(qp + kq * 32);
 }
    f32x4 O[8][2];
    float mrun[2], lrun[2], invl[2] = {0.f, 0.f};
    const LAS unsigned long long* selm = SELM + 8 * w + (l16 >> 2);
    u32x4 kr[2], vr[2];
    TileDesc td;
#define O_ZERO() do { _Pragma("unroll") for (int dt = 0; dt < 8; ++dt) { O[dt][0] = (f32x4){0.f, 0.f, 0.f, 0.f}; O[dt][1] = O[dt][0]; } } while (0)
    const int ncmp = ((t0 + 32) >> 10) + 1 > 4 ? 4 : ((t0 + 32) >> 10) + 1;
    const bf16_t* KC = (const bf16_t*)(ws + WS_KC) + (size_t)bg * 256 * 128; const bf16_t* VCT = (const bf16_t*)(ws + WS_VCT) + (size_t)bg * 128 * 256;
    td.kstr = 128; td.vstr = 256; td.kstep = 16; td.wlim = 1 << 30; td.selj = -1;
    mrun[0] = mrun[1] = NEGL; lrun[0] = lrun[1] = 0.f;
    __syncthreads();
    for (int pass = 0; pass < 2; ++pass) {
        if (pass == 1) {
#pragma unroll
            for (int nt = 0; nt < 2; ++nt) { float l = lrun[nt]; l += __shfl_xor(l, 16); l += __shfl_xor(l, 32); invl[nt] = l > 0.f ? 1.0f / l : 0.f; }
            O_ZERO();
        }
        for (int kt = 0; kt < ncmp; ++kt) {
            td.K = KC + (size_t)kt * 64 * 128; td.V = VCT + kt * 64; td.kp0 = 1024 * kt + 31;
            nsa_load(td, tid, kr, vr); nsa_store(Kb0, Vb0, tid, kr, vr);
            __syncthreads();
            if (pass == 0) nsa_tile<0, 3>(Kb0, Vb0, TB, td, qf, tq, selm, hh, l16, g4, O, mrun, lrun, invl, PA, PBv, w, kt, t0, true);
            else nsa_tile<1, 3>(Kb0, Vb0, TB, td, qf, tq, selm, hh, l16, g4, O, mrun, lrun, invl, PA, PBv, w, kt, t0, true);
            __syncthreads();
        }
    }
    bf16_t* MIXA = (bf16_t*)(ws + WS_HB) + 2048 + (g * 4 + hh) * 128 + 4 * g4;
#pragma unroll
    for (int nt = 0; nt < 2; ++nt) { const float c = sigm(GATES[((size_t)b * T + tq[nt]) * 64 + 8 + (g * 4 + hh) * 3]); bf16_t* mp = MIXA + ((size_t)b * T + tq[nt]) * D;
#pragma unroll
        for (int dt = 0; dt < 8; ++dt) { u32x2 o; o.x = pk_bf16(O[dt][nt][0] * c, O[dt][nt][1] * c); o.y = pk_bf16(O[dt][nt][2] * c, O[dt][nt][3] * c); *(u32x2*)(mp + 16 * dt) = o; } }
    {
        unsigned long long uni = 0ull;
        const unsigned long long validmask = (qb >= 63) ? ~0ull : ((1ull << (qb + 1)) - 1ull);
        for (int ti = 0; ti < 8; ++ti) { const int tok = 8 * w + ti, j = lane;
            const bool valid = j <= qb, forced = (j == 0) || (j == qb) || (j == qb - 1);
            const float score = (PA[tok * 65 + j] + PBv[tok * 65 + j]) + (forced ? 1000.f : 0.f);
            const unsigned key = valid ? __float_as_uint(score) : 0u;
            unsigned thr = 0u;
#pragma unroll
            for (int bit = 31; bit >= 0; --bit) { const unsigned cand = thr | (1u << bit); if (__popcll(__ballot(key >= cand)) >= 16) thr = cand; }
            unsigned long long sel = __ballot(key > thr), eq = __ballot(key == thr);
            for (int need = 16 - __popcll(sel); need > 0; --need) { const unsigned long long b = eq & (0ull - eq); sel |= b; eq ^= b; }
            const unsigned long long msk = sel & validmask;
            if (lane == 0) SELM[tok] = msk;
            uni |= msk; }
        if (lane == 0) UNI[w] = uni;
    }
    __syncthreads();
    unsigned long long uni = 0ull;
#pragma unroll
    for (int i = 0; i < 8; ++i) uni |= UNI[i];
    for (int br = 1; br < 3; ++br) {
        unsigned long long rem;
        if (br == 1) { rem = uni; td.kstr = NP; td.vstr = T; td.kstep = 1; td.wlim = 1 << 30; }
        else { const int lo = qb >= 8 ? 0 : 8 - qb; rem = (0x1ffull >> lo) << lo; td.kstr = NP; td.vstr = T; td.kstep = 1; td.wlim = 512; td.selj = -1; }
        const bf16_t* Kbase = PROJ + (size_t)b * T * NP + (br == 1 ? C_SK : C_WK) + g * 128;
        const bf16_t* Vbase = (const bf16_t*)(ws + (br == 1 ? WS_SVT : WS_WVT)) + (size_t)bg * 128 * T;
        mrun[0] = mrun[1] = NEGL; lrun[0] = lrun[1] = 0.f; O_ZERO();
        int j = __builtin_ctzll(rem); rem &= rem - 1;
        { const int s0 = (br == 1) ? 64 * j : t0 - 512 + 64 * j; td.K = Kbase + (size_t)s0 * NP; td.V = Vbase + s0; td.kp0 = s0; if (br == 1) td.selj = j; }
        nsa_load(td, tid, kr, vr); nsa_store(Kb0, Vb0, tid, kr, vr);
        __syncthreads();
        int buf = 0;
        for (;;) {
            const int jn = rem ? __builtin_ctzll(rem) : -1;
            TileDesc tn = td;
            if (jn >= 0) { const int s0 = (br == 1) ? 64 * jn : t0 - 512 + 64 * jn; tn.K = Kbase + (size_t)s0 * NP; tn.V = Vbase + s0; tn.kp0 = s0; if (br == 1) tn.selj = jn; nsa_load(tn, tid, kr, vr); }
            const bool msk = (br == 1) ? (j == qb) : (j == 0 || j == 8);
            {
                const bool a0 = (td.selj < 0) || ((selm[0] >> td.selj) & 1ull), a1 = (td.selj < 0) || ((selm[4] >> td.selj) & 1ull);
                const bool any0 = __builtin_amdgcn_ballot_w64(a0) != 0ull, any1 = __builtin_amdgcn_ballot_w64(a1) != 0ull;
                const LAS bf16_t* kb = Kb0 + buf * 64 * 136; const LAS bf16_t* vb = Vb0 + buf * 128 * 72;
                if (any0 || any1) nsa_tile<2, 3>(kb, vb, TB, td, qf, tq, selm, hh, l16, g4, O, mrun, lrun, invl, PA, PBv, w, 0, t0, msk);
            }
            if (jn >= 0) nsa_store(Kb0 + (buf ^ 1) * 64 * 136, Vb0 + (buf ^ 1) * 128 * 72, tid, kr, vr);
            __syncthreads();
            if (jn < 0) break;
            rem &= rem - 1; td = tn; buf ^= 1; j = jn;
        }
#pragma unroll
        for (int nt = 0; nt < 2; ++nt) { float l = lrun[nt]; l += __shfl_xor(l, 16); l += __shfl_xor(l, 32); const size_t row = (size_t)b * T + tq[nt]; bf16_t* mp = MIXA + row * D;
            const float gsel = sigm(GATES[row * 64 + 8 + (g * 4 + hh) * 3 + br]); const float c = l > 0.f ? gsel / l : 0.f;
#pragma unroll
            for (int dt = 0; dt < 8; ++dt) { const u32x2 prev = *(const u32x2*)(mp + 16 * dt);
                const float o0 = bflo(prev.x) + O[dt][nt][0] * c, o1 = bfhi(prev.x) + O[dt][nt][1] * c, o2 = bflo(prev.y) + O[dt][nt][2] * c, o3 = bfhi(prev.y) + O[dt][nt][3] * c;
                u32x2 o;
                if (br == 1) { o.x = pk_bf16(o0, o1); o.y = pk_bf16(o2, o3); }
                else { const u32x2 z = *(const u32x2*)(PROJ + row * NP + C_AZ + (g * 4 + hh) * 128 + 16 * dt + 4 * g4);
                    o.x = pk_bf16(o0 * siluf(bflo(z.x)), o1 * siluf(bfhi(z.x))); o.y = pk_bf16(o2 * siluf(bflo(z.y)), o3 * siluf(bfhi(z.y))); }
                *(u32x2*)(mp + 16 * dt) = o; } }
    }
    __syncthreads();
#undef O_ZERO
}

__device__ void phase4(const Args& a) {
    const int tid = threadIdx.x, lane = tid & 63;
    unsigned char* ws = a.ws;
    const bf16_t* PROJ = (const bf16_t*)(ws + WS_PROJ); const bf16_t* HM = (const bf16_t*)(ws + WS_HM); const float* SS = (const float*)(ws + WS_SS);
    bf16_t* MIX = (bf16_t*)(ws + WS_HB); const float* gain = a.in[6];
    const int gw = blockIdx.x * 8 + (tid >> 6), nw = gridDim.x * 8;
    for (int it = gw; it < MROWS * 4; it += nw) {
        const int row = it >> 2, h = it & 3, c8 = h * 512 + lane * 8;
        const u32x4 hv = *(const u32x4*)(HM + (size_t)row * 2048 + c8), zv = *(const u32x4*)(PROJ + (size_t)row * NP + C_MZ + c8);
        const float sp = SS[(size_t)it * 32 + (lane & 31)];
        float s = sp; s += __shfl_xor(s, 1); s += __shfl_xor(s, 2); s += __shfl_xor(s, 4); s += __shfl_xor(s, 8); s += __shfl_xor(s, 16);
        const float rstd = 1.0f / sqrtf(s * (1.0f / 512.f) + 1e-6f);
        const f32x4 g0 = *(const f32x4*)(gain + c8), g1 = *(const f32x4*)(gain + c8 + 4);
        u32x4 o;
        o.x = pk_bf16(bflo(hv.x) * rstd * g0[0] * siluf(bflo(zv.x)), bfhi(hv.x) * rstd * g0[1] * siluf(bfhi(zv.x)));
        o.y = pk_bf16(bflo(hv.y) * rstd * g0[2] * siluf(bflo(zv.y)), bfhi(hv.y) * rstd * g0[3] * siluf(bfhi(zv.y)));
        o.z = pk_bf16(bflo(hv.z) * rstd * g1[0] * siluf(bflo(zv.z)), bfhi(hv.z) * rstd * g1[1] * siluf(bfhi(zv.z)));
        o.w = pk_bf16(bflo(hv.w) * rstd * g1[2] * siluf(bflo(zv.w)), bfhi(hv.w) * rstd * g1[3] * siluf(bfhi(zv.w)));
        *(u32x4*)(MIX + (size_t)row * D + c8) = o;
    }
}

__device__ void phase6(const Args& a) {
    const int tid = threadIdx.x, lane = tid & 63;
    float* out = a.out; const float* x = a.in[0]; const float* gain = a.in[15];
    const int gw = blockIdx.x * 8 + (tid >> 6), nw = gridDim.x * 8;
    for (int row = gw; row < MROWS; row += nw) {
        f32x4* orow = (f32x4*)(out + (size_t)row * D); const f32x4* xr = (const f32x4*)(x + (size_t)row * D);
        const u32x2* pr = (const u32x2*)((const bf16_t*)(a.ws + WS_PROJ) + (size_t)row * D);
        f32x4 v[16]; float ss = 0.f;
#pragma unroll
        for (int i = 0; i < 16; ++i) { const u32x2 pv = pr[lane + 64 * i]; const f32x4 xv = xr[lane + 64 * i];
            v[i][0] = bflo(pv.x) + xv[0]; v[i][1] = bfhi(pv.x) + xv[1]; v[i][2] = bflo(pv.y) + xv[2]; v[i][3] = bfhi(pv.y) + xv[3];
            ss += (v[i][0] * v[i][0] + v[i][1] * v[i][1]) + (v[i][2] * v[i][2] + v[i][3] * v[i][3]); }
        ss = wave_sum(ss);
        const float rstd = 1.0f / sqrtf(ss * (1.0f / D) + 1e-6f);
#pragma unroll
        for (int i = 0; i < 16; ++i) { const f32x4 g = ((const f32x4*)gain)[lane + 64 * i]; f32x4 o;
            o[0] = v[i][0] * rstd * g[0]; o[1] = v[i][1] * rstd * g[1]; o[2] = v[i][2] * rstd * g[2]; o[3] = v[i][3] * rstd * g[3]; orow[lane + 64 * i] = o; }
    }
}

__global__ void __launch_bounds__(NTHREADS, 2) hymba_fwd(Args a) {
    extern __shared__ __attribute__((aligned(16))) unsigned char lds_raw[];
    LAS unsigned char* lds = (LAS unsigned char*)lds_raw;
    cg::grid_group grid = cg::this_grid();
    volatile LAS unsigned* xb_st = (volatile LAS unsigned*)(lds + (LDS_BYTES - 16));
    if (threadIdx.x < 4) xb_st[threadIdx.x] = 0u;
    __syncthreads();
    unsigned* xb_words = (unsigned*)(a.ws + WS_BAR);
    XcdBarrier xbar; xbar.bar = xb_words; xbar.x = 0u; xbar.st = xb_st;
    const int lo = a.ph_lo, hi = a.ph_hi;
#ifdef STAMP_SEL
    unsigned long long* stamps = (unsigned long long*)(a.ws + WS_END2);
#define STAMP(k) do { if (blockIdx.x == 0 && threadIdx.x == 0) stamps[k] = __builtin_amdgcn_s_memrealtime(); } while (0)
#else
#define STAMP(k) do { } while (0)
#endif
    STAMP(0);
#ifndef PH_MASK
#define PH_MASK 0x7f
#endif
#define IN(k) (((PH_MASK >> (k)) & 1) && lo <= (k) && (k) < hi)
#define SEAM(k) do { if ((k) + 1 < hi) { if ((k) == 0) { asm volatile("s_waitcnt vmcnt(0)" ::: "memory"); grid.sync(); xbar = xcd_barrier_post(xb_words, xb_st); } else xcd_barrier(xbar); } } while (0)
    if (IN(0)) { if (blockIdx.x == 0) for (int i = threadIdx.x; i < XCD_BAR_WORDS; i += NTHREADS) xb_words[i] = 0u;
        for (int rep = 0; rep < REP_P0; ++rep) phase0(a, lds); SEAM(0); STAMP(1); }
    if (IN(1)) { for (int rep = 0; rep < REP_P1; ++rep) {
        pg8::Gemm g{(const bf16_t*)(a.ws + WS_HB), (const bf16_t*)(a.ws + WS_WIN), MROWS, NP, D};
        pg8::StaticOrder S; S.init(MROWS, NP, gridDim.x, blockIdx.x);
        pg8::EpiProj E{(bf16_t*)(a.ws + WS_PROJ), NP};
        pg8::gemm_phase<pg8::EpiProj>(lds, g, S, E);
        gate_gemm(a, lds); }
        SEAM(1); STAMP(2);
    }
    if (IN(2)) { for (int rep = 0; rep < REP_P2; ++rep) phase2(a, lds); SEAM(2); STAMP(3); }
    if (IN(3)) {
#ifndef NO_MLSTM
        for (int rep = 0; rep < REP_ML; ++rep)
        for (int item = blockIdx.x; item < 256; item += gridDim.x) mlstm_item(a, lds, item);
#endif
        __syncthreads();
        STAMP(4);
#ifndef NO_NSA
        for (int rep = 0; rep < REP_NSA; ++rep)
        for (int p2 = blockIdx.x * 2; p2 < 1024; p2 += gridDim.x * 2)
            for (int u = 0; u < 2; ++u) { const int p = p2 >> 1, bg = p & 15, qq = p >> 4; nsa_unit(a, lds, bg, u ? qq : 63 - qq); }
#endif
        SEAM(3); STAMP(5);
    }
    if (IN(4)) { phase4(a); SEAM(4); STAMP(6); }
    if (IN(5)) { for (int rep = 0; rep < REP_P5; ++rep) {
        pg8::Gemm g{(const bf16_t*)(a.ws + WS_HB), (const bf16_t*)(a.ws + WS_WOUT), MROWS, D, D};
        pg8::StaticOrder S; S.init(MROWS, D, gridDim.x, blockIdx.x);
        pg8::EpiProj E{(bf16_t*)(a.ws + WS_PROJ), D};
        pg8::gemm_phase<pg8::EpiProj>(lds, g, S, E); }
        SEAM(5); STAMP(7);
    }
    if (IN(6)) { phase6(a); }
#ifdef STAMP_SEL
    __builtin_amdgcn_fence(__ATOMIC_RELEASE, "agent"); grid.sync(); __builtin_amdgcn_fence(__ATOMIC_ACQUIRE, "agent");
    if (blockIdx.x == 0) { STAMP(8); __syncthreads();
        const unsigned long long k = stamps[STAMP_SEL + 1] - stamps[STAMP_SEL];
        for (unsigned long long i = threadIdx.x; i < k; i += NTHREADS) a.out[i] += 0.0625f; }
#endif
#undef IN
#undef SEAM
}

extern "C" void kernel_launch(void* const* d_in, const int* in_sizes, int n_in, void* d_out, int out_size, void* d_ws, size_t ws_size, hipStream_t stream) {
    static int grid = 0;
    if (grid == 0) {
        if (n_in != 16 || ws_size < WS_END3) { fprintf(stderr, "kernel_launch: bad inputs (n_in %d, ws %zu, need %zu)\n", n_in, ws_size, (size_t)WS_END); grid = -1; return; }
        int dev = 0, cus = 0, per_cu = 0;
        (void)hipGetDevice(&dev);
        (void)hipDeviceGetAttribute(&cus, hipDeviceAttributeMultiprocessorCount, dev);
        if (hipFuncSetAttribute((const void*)hymba_fwd, hipFuncAttributeMaxDynamicSharedMemorySize, LDS_BYTES) != hipSuccess) { fprintf(stderr, "kernel_launch: hipFuncSetAttribute failed\n"); grid = -1; return; }
        if (hipOccupancyMaxActiveBlocksPerMultiprocessor(&per_cu, (const void*)hymba_fwd, NTHREADS, LDS_BYTES) != hipSuccess || per_cu < 1) { fprintf(stderr, "kernel_launch: occupancy query says %d\n", per_cu); per_cu = 1; }
        (void)hipGetLastError();
        grid = cus * 1;
    }
    if (grid < 0) return;
    Args a{};
    for (int i = 0; i < 16; ++i) a.in[i] = (const float*)d_in[i];
    a.out = (float*)d_out; a.ws = (unsigned char*)d_ws;
#if N_LAUNCH_SPLIT
    for (int ph = 0; ph < 7; ++ph) { a.ph_lo = ph; a.ph_hi = ph + 1; hipLaunchKernelGGL(hymba_fwd, dim3(grid), dim3(NTHREADS), LDS_BYTES, stream, a); }
#else
    a.ph_lo = 0; a.ph_hi = 7;
    void* args[] = {&a};
    hipError_t e = hipLaunchCooperativeKernel((const void*)hymba_fwd, dim3(grid), dim3(NTHREADS), args, LDS_BYTES, stream);
    if (e != hipSuccess) fprintf(stderr, "cooperative launch failed: %s (grid %d)\n", hipGetErrorString(e), grid);
#endif
}
```

```cpp
#include <hip/hip_runtime.h>
#include <hip/hip_cooperative_groups.h>
#include <cstdio>
namespace cg = cooperative_groups;

#ifndef REP_P0
#define REP_P0 1
#endif
#ifndef REP_P1
#define REP_P1 1
#endif
#ifndef REP_P2
#define REP_P2 1
#endif
#ifndef REP_ML
#define REP_ML 1
#endif
#ifndef REP_NSA
#define REP_NSA 1
#endif
#ifndef REP_P5
#define REP_P5 1
#endif
#ifndef N_LAUNCH_SPLIT
#define N_LAUNCH_SPLIT 0
#endif

#define LAS __attribute__((address_space(3)))
typedef unsigned short bf16_t;
typedef short bf16x8 __attribute__((ext_vector_type(8)));
typedef short bf16x4 __attribute__((ext_vector_type(4)));
typedef float f32x4 __attribute__((ext_vector_type(4)));
typedef unsigned u32x4 __attribute__((ext_vector_type(4)));
typedef unsigned u32x2 __attribute__((ext_vector_type(2)));

constexpr int NB = 4, T = 4096, D = 4096, MROWS = NB * T;
constexpr int NP = 15360;
constexpr int NWIN = 15424;
constexpr int W_IN_COLS = 15416;
constexpr int C_MQ = 0, C_MK = 1024, C_MV = 2048, C_MO = 4096, C_MZ = 6144, C_AQ = 8192, C_CK = 10240, C_CV = 10752,
              C_SK = 11264, C_SV = 11776, C_WK = 12288, C_WV = 12800, C_AZ = 13312;
constexpr int NTHREADS = 512;
constexpr int LDS_BYTES = 147456;

#define XCD_BAR_WORDS 3456
constexpr size_t WS_HB = 0;
constexpr size_t WS_WIN = WS_HB + (size_t)MROWS * D * 2;
constexpr size_t WS_WOUT = WS_WIN + (size_t)NWIN * D * 2;
constexpr size_t WS_PROJ = WS_WOUT + (size_t)D * D * 2;
constexpr size_t WS_GATES = WS_PROJ + (size_t)MROWS * NP * 2;
constexpr size_t WS_QKC = WS_GATES + (size_t)MROWS * 64 * 4;
constexpr size_t WS_SVT = WS_QKC + (size_t)MROWS * 2048 * 2;
constexpr size_t WS_WVT = WS_SVT + (size_t)16 * 128 * 4096 * 2;
constexpr size_t WS_KC = WS_WVT + (size_t)16 * 128 * 4096 * 2;
constexpr size_t WS_VCT = WS_KC + (size_t)16 * 256 * 128 * 2;
constexpr size_t WS_W1T = WS_VCT + (size_t)16 * 256 * 128 * 2;
constexpr size_t WS_W2T = WS_W1T + (size_t)2 * 128 * 4096 * 2;
constexpr size_t WS_PB = WS_W2T + (size_t)2 * 128 * 128 * 2;
constexpr size_t WS_HM = WS_PB + 1024;
constexpr size_t WS_SS = WS_HM + (size_t)MROWS * 2048 * 2;
constexpr size_t WS_SSQ = WS_SS + (size_t)MROWS * 128 * 4;
constexpr size_t WS_END = WS_SSQ + (size_t)MROWS * 64 * 4;
constexpr size_t WS_KT = WS_END;
constexpr size_t WS_END2 = WS_KT + (size_t)4 * 1024 * T * 2;
constexpr size_t WS_BAR = WS_END2 + 256;
constexpr size_t WS_END3 = WS_BAR + (size_t)XCD_BAR_WORDS * 4;
static_assert(WS_END3 <= ((size_t)1 << 30), "workspace map must fit 1 GiB");

struct Args { const float* in[16]; float* out; unsigned char* ws; int ph_lo, ph_hi; };

__device__ __forceinline__ unsigned pk_bf16(float lo, float hi) { unsigned r; asm("v_cvt_pk_bf16_f32 %0, %1, %2" : "=v"(r) : "v"(lo), "v"(hi)); return r; }
__device__ __forceinline__ bf16_t f2bf(float f) { return (bf16_t)(pk_bf16(f, 0.f) & 0xffffu); }
__device__ __forceinline__ float bf2f(unsigned b) { return __uint_as_float(b << 16); }
__device__ __forceinline__ float bflo(unsigned w) { return __uint_as_float(w << 16); }
__device__ __forceinline__ float bfhi(unsigned w) { return __uint_as_float(w & 0xffff0000u); }
__device__ __forceinline__ float wave_sum(float v) {
#pragma unroll
    for (int o = 32; o >= 1; o >>= 1) v += __shfl_xor(v, o);
    return v;
}
__device__ __forceinline__ float colgroup_max(float x) {
    const unsigned xi = __float_as_uint(x);
    const auto r = __builtin_amdgcn_permlane32_swap(xi, xi, false, false);
    const float m1 = fmaxf(__uint_as_float(r[0]), __uint_as_float(r[1]));
    const unsigned mi = __float_as_uint(m1);
    const auto r2 = __builtin_amdgcn_permlane16_swap(mi, mi, false, false);
    return fmaxf(__uint_as_float(r2[0]), __uint_as_float(r2[1]));
}
__device__ __forceinline__ float siluf(float x) { return x / (1.f + __expf(-x)); }
__device__ __forceinline__ float sigm(float x) { return 1.f / (1.f + __expf(-x)); }
__device__ __forceinline__ f32x4 mfma16(bf16x8 a, bf16x8 b, f32x4 c) { return __builtin_amdgcn_mfma_f32_16x16x32_bf16(a, b, c, 0, 0, 0); }
__device__ __forceinline__ bf16x8 as_bf16x8(u32x4 v) { union { u32x4 u; bf16x8 b; } x; x.u = v; return x.b; }

#define XB_TMO      128
#define XB_XCNT(j)  (256  + 64 * (j))
#define XB_XSUB(j)  (1280 + 64 * (j))
#define XB_XGEN(j)  (2304 + 64 * (j))
#define XB_TOP      3328
#define XB_TOPGEN   3392
#define XB_SPIN_CAP (1u << 18)
__device__ __forceinline__ unsigned xb_ld(unsigned* p)              { return __hip_atomic_load(p, __ATOMIC_RELAXED, __HIP_MEMORY_SCOPE_AGENT); }
__device__ __forceinline__ unsigned xb_add(unsigned* p, unsigned v) { return __hip_atomic_fetch_add(p, v, __ATOMIC_RELAXED, __HIP_MEMORY_SCOPE_AGENT); }
__device__ __forceinline__ unsigned xb_xcc_id() { return (unsigned)__builtin_amdgcn_s_getreg((3 << 11) | 20) & 0xFu; }
#define XB_SPIN(cond, bar) do { unsigned _sp = 0; while (cond) { __builtin_amdgcn_s_sleep(1); \
    if ((++_sp & 255u) == 0u) { if (xb_ld(&(bar)[XB_TMO])) break; if (_sp > XB_SPIN_CAP) { atomicAdd(&(bar)[XB_TMO], 1u); break; } } } } while (0)
struct XcdBarrier { unsigned* bar; unsigned x; volatile LAS unsigned* st; };
__device__ __forceinline__ XcdBarrier xcd_barrier_post(unsigned* bar, volatile LAS unsigned* st) {
    XcdBarrier b; b.bar = bar; b.x = xb_xcc_id(); b.st = st;
    if (threadIdx.x == 0) (void)xb_add(&bar[XB_XCNT(b.x)], 1u);
    return b;
}
__device__ __forceinline__ void xcd_barrier_complete(unsigned* bar, unsigned x, unsigned& nloc, unsigned& nx) {
    const unsigned G = gridDim.x * gridDim.y * gridDim.z;
    unsigned sum, cnt, mine, sp = 0u;
    for (;;) {
        sum = 0u; cnt = 0u; mine = 0u;
#pragma unroll
        for (unsigned j = 0; j < 16; ++j) { const unsigned c = xb_ld(&bar[XB_XCNT(j)]); sum += c; cnt += (c > 0u) ? 1u : 0u; mine = (j == x) ? c : mine; }
        if (sum == G) break;
        __builtin_amdgcn_s_sleep(1);
        if ((++sp & 255u) == 0u) { if (xb_ld(&bar[XB_TMO])) break; if (sp > XB_SPIN_CAP) { atomicAdd(&bar[XB_TMO], 1u); break; } }
    }
    nloc = mine > 0u ? mine : 1u; nx = cnt > 0u ? cnt : 1u;
}
__device__ __forceinline__ void xcd_barrier(const XcdBarrier& b) {
    asm volatile("s_waitcnt vmcnt(0)" ::: "memory");
    __syncthreads();
    if (threadIdx.x == 0) {
        unsigned* bar = b.bar;
        __builtin_amdgcn_s_waitcnt(0);
        unsigned nloc = b.st[0], nx = b.st[1];
        if (nloc == 0u) { xcd_barrier_complete(bar, b.x, nloc, nx); b.st[0] = nloc; b.st[1] = nx; }
        const unsigned old = xb_add(&bar[XB_XSUB(b.x)], 1u);
        const unsigned gen = old / nloc;
        if (old + 1u == (gen + 1u) * nloc) {
            __builtin_amdgcn_fence(__ATOMIC_RELEASE, "agent");
            asm volatile("s_waitcnt vmcnt(0)" ::: "memory");
            const unsigned og = xb_add(&bar[XB_TOP], 1u);
            const unsigned tg = og / nx;
            if (og + 1u == (tg + 1u) * nx) xb_add(&bar[XB_TOPGEN], 1u);
            else XB_SPIN(xb_ld(&bar[XB_TOPGEN]) == tg, bar);
            __builtin_amdgcn_fence(__ATOMIC_ACQUIRE, "agent");
            xb_add(&bar[XB_XGEN(b.x)], 1u);
            asm volatile("s_waitcnt vmcnt(0)" ::: "memory");
        } else {
            XB_SPIN(xb_ld(&bar[XB_XGEN(b.x)]) == gen, bar);
            __builtin_amdgcn_fence(__ATOMIC_ACQUIRE, "agent");
            asm volatile("s_waitcnt vmcnt(0)" ::: "memory");
        }
    }
    __syncthreads();
}

namespace pg8 {
constexpr int BM = 256, BK = 64, HALF = 128, HTB = HALF * BK * 2, STAGE_BYTES = 8 * HTB, NXCD = 8, WGM = 8;
__host__ __device__ __forceinline__ int lds_byte(int r, int c) { const int st = (r >> 4) * 2 + (c >> 5), rr = r & 15, cc = c & 31, ob = rr * 64 + cc * 2; return st * 1024 + (ob ^ (((ob >> 9) & 1) << 5)); }
__host__ __device__ __forceinline__ void stage_rc(int b, int& R, int& C) { const int st = b / 1024, sb = b % 1024, swz = sb ^ (((sb >> 9) & 1) << 5); R = (st >> 1) * 16 + swz / 64; C = (st & 1) * 32 + (swz % 64) / 2; }
__host__ __device__ __forceinline__ int perm32(int rho) { const int n = rho >> 4, i = rho & 15; return 8 * (i >> 2) + 4 * n + (i & 3); }
struct Unit { int pm, pn; };
struct Gemm { const bf16_t* A; const bf16_t* Bt; int M, N, K; };
struct StaticOrder {
    int nM, nN, nwg, G, c;
    __device__ void init(int M, int N, int G_, int c_) { nM = M / BM; nN = N / BM; nwg = nM * nN; G = G_; c = c_; }
    __device__ bool next(int i, Unit& u) const {
        const long L = (long)i * G + c; if (L >= nwg) return false;
        int wgid = (int)L; { const int q = nwg / NXCD, r = nwg % NXCD, xcd = wgid % NXCD, off = wgid / NXCD; wgid = (xcd < r ? xcd * (q + 1) : r * (q + 1) + (xcd - r) * q) + off; }
        const int nig = WGM * nN, gid = wgid / nig, fm = gid * WGM, gsz = (nM - fm) < WGM ? (nM - fm) : WGM;
        u.pm = fm + ((wgid % nig) % gsz); u.pn = (wgid % nig) / gsz; return true;
    }
};

template <class Epi, bool ALIGN_EPI = true, bool SP2 = true>
__device__ __forceinline__ void gemm_phase(LAS unsigned char* lds, const Gemm g, const StaticOrder& S, const Epi& E) {
    const int tid = threadIdx.x, wid = __builtin_amdgcn_readfirstlane(tid >> 6), lane = tid & 63, wr = wid >> 2, wc = wid & 3, fr = lane & 15, fq = lane >> 4;
    const int K = g.K, nt = K / BK;
    unsigned voffA[2], voffB[2];
#pragma unroll
    for (int i = 0; i < 2; ++i) { int R, C; stage_rc(tid * 16 + i * 8192, R, C); const int Rb = Epi::PERM ? ((R & ~31) + perm32(R & 31)) : R;
        voffA[i] = (unsigned)(R * K + C) * 2u; voffB[i] = (unsigned)(Rb * K + C) * 2u; }
    const size_t kstep = (size_t)(BK * 2);
    const size_t hstep = (size_t)HALF * K * 2;
    const size_t tstep = 2 * hstep;
    const unsigned ldsw = (unsigned)wid * 1024u;
    const int aoff = lds_byte(wr * 64 + fr, fq * 8), boff = lds_byte(wc * 32 + fr, fq * 8);
#define PG8_SA(b, h) (((b) * 2 + (h)) * HTB)
#define PG8_SB(b, h) ((4 + (b) * 2 + (h)) * HTB)
#define PG8_STAGE(bufoff, gbase, voff) do { _Pragma("unroll") for (int _i = 0; _i < 2; ++_i) \
        __builtin_amdgcn_global_load_lds((const unsigned*)((const char*)(gbase) + (voff)[_i]), (LAS unsigned*)(lds + (bufoff) + ldsw + _i * 8192), 16, 0, 0); } while (0)
#define PG8_LDA(dst, b, h) do { _Pragma("unroll") for (int m = 0; m < 4; ++m) _Pragma("unroll") for (int k = 0; k < 2; ++k) dst[m][k] = *(const LAS bf16x8*)(lds + PG8_SA(b, h) + aoff + m * 2048 + k * 1024); } while (0)
#define PG8_LDB(dst, b, h) do { _Pragma("unroll") for (int n = 0; n < 2; ++n) _Pragma("unroll") for (int k = 0; k < 2; ++k) dst[n][k] = *(const LAS bf16x8*)(lds + PG8_SB(b, h) + boff + n * 2048 + k * 1024); } while (0)
#define PG8_MMA(ai, bj, At, Bt) do { __builtin_amdgcn_s_setprio(1); _Pragma("unroll") for (int m = 0; m < 4; ++m) _Pragma("unroll") for (int n = 0; n < 2; ++n) _Pragma("unroll") for (int k = 0; k < 2; ++k) \
        acc[ai][bj][m][n] = __builtin_amdgcn_mfma_f32_16x16x32_bf16(Bt[n][k], At[m][k], acc[ai][bj][m][n], 0, 0, 0); __builtin_amdgcn_s_setprio(0); } while (0)
#define PG8_WAIT_V(n) asm volatile("s_waitcnt vmcnt(" #n ")" ::: "memory")
#define PG8_WAIT_L(n) asm volatile("s_waitcnt lgkmcnt(" #n ")" ::: "memory")
#define PG8_BAR __builtin_amdgcn_s_barrier()
#define PG8_SCHED __builtin_amdgcn_sched_barrier(0)
    Unit cur, nxt; int ui = 0;
    if (!S.next(0, cur)) return;
    f32x4 acc[2][2][4][2];
#pragma unroll
    for (int a = 0; a < 2; ++a)
#pragma unroll
        for (int b = 0; b < 2; ++b)
#pragma unroll
            for (int m = 0; m < 4; ++m)
#pragma unroll
                for (int n = 0; n < 2; ++n) acc[a][b][m][n] = (f32x4){0.f, 0.f, 0.f, 0.f};
    bf16x8 At[4][2], B0[2][2], B1[2][2];
    const char* cA = (const char*)g.A + (size_t)cur.pm * tstep; const char* cB = (const char*)g.Bt + (size_t)cur.pn * tstep;
    if constexpr (SP2) {
        PG8_STAGE(PG8_SB(0, 0), cB, voffB); PG8_STAGE(PG8_SB(0, 1), cB + hstep, voffB); PG8_STAGE(PG8_SA(0, 0), cA, voffA); PG8_STAGE(PG8_SA(0, 1), cA + hstep, voffA);
        if (wr == 1) PG8_BAR;
        PG8_WAIT_V(2); PG8_BAR;
        PG8_STAGE(PG8_SB(1, 0), cB + kstep, voffB); PG8_STAGE(PG8_SA(1, 0), cA + kstep, voffA); PG8_STAGE(PG8_SB(1, 1), cB + hstep + kstep, voffB);
        PG8_WAIT_V(6); PG8_BAR;
    } else {
    PG8_STAGE(PG8_SB(0, 0), cB, voffB); PG8_STAGE(PG8_SA(0, 0), cA, voffA); PG8_STAGE(PG8_SB(0, 1), cB + hstep, voffB); PG8_STAGE(PG8_SA(0, 1), cA + hstep, voffA);
    if (wr == 1) PG8_BAR;
    PG8_WAIT_V(4); PG8_BAR;
    PG8_STAGE(PG8_SB(1, 0), cB + kstep, voffB); PG8_STAGE(PG8_SA(1, 0), cA + kstep, voffA); PG8_STAGE(PG8_SB(1, 1), cB + hstep + kstep, voffB);
    PG8_WAIT_V(6); PG8_BAR;
    }
    for (;;) {
        const bool has_next = S.next(ui + 1, nxt);
        const char* nA = has_next ? (const char*)g.A + (size_t)nxt.pm * tstep : cA; const char* nB = has_next ? (const char*)g.Bt + (size_t)nxt.pn * tstep : cB;
        for (int t = 0; t < nt; t += 2) {
            const bool last = (t == nt - 2);
            const char* a1 = cA + (size_t)(t + 1) * kstep;
            const char* a2 = last ? nA : cA + (size_t)(t + 2) * kstep; const char* b2 = last ? nB : cB + (size_t)(t + 2) * kstep;
            const char* a3 = a2 + kstep; const char* b3 = b2 + kstep;
            if constexpr (SP2) {
            PG8_LDB(B0, 0, 0); PG8_LDB(B1, 0, 1); PG8_SCHED; PG8_LDA(At, 0, 0); PG8_STAGE(PG8_SA(1, 1), a1 + hstep, voffA);
            PG8_WAIT_V(8); PG8_WAIT_L(0); PG8_BAR; PG8_MMA(0, 0, At, B0); PG8_MMA(0, 1, At, B1); PG8_BAR; PG8_SCHED;
            PG8_LDA(At, 0, 1); PG8_STAGE(PG8_SB(0, 0), b2, voffB); PG8_STAGE(PG8_SB(0, 1), b2 + hstep, voffB); PG8_STAGE(PG8_SA(0, 0), a2, voffA);
            PG8_WAIT_V(8); PG8_WAIT_L(0); PG8_BAR; PG8_MMA(1, 0, At, B0); PG8_MMA(1, 1, At, B1); PG8_BAR; PG8_SCHED;
            PG8_LDB(B0, 1, 0); PG8_LDB(B1, 1, 1); PG8_SCHED; PG8_LDA(At, 1, 0); PG8_STAGE(PG8_SA(0, 1), a2 + hstep, voffA);
            PG8_WAIT_V(8); PG8_WAIT_L(0); PG8_BAR; PG8_MMA(0, 0, At, B0); PG8_MMA(0, 1, At, B1); PG8_BAR; PG8_SCHED;
            PG8_LDA(At, 1, 1); PG8_STAGE(PG8_SB(1, 0), b3, voffB); PG8_STAGE(PG8_SB(1, 1), b3 + hstep, voffB); PG8_STAGE(PG8_SA(1, 0), a3, voffA);
            PG8_WAIT_V(8); PG8_WAIT_L(0); PG8_BAR; PG8_MMA(1, 0, At, B0); PG8_MMA(1, 1, At, B1); PG8_BAR; PG8_SCHED;
            } else {
            PG8_LDB(B0, 0, 0); PG8_SCHED; PG8_LDA(At, 0, 0); PG8_STAGE(PG8_SA(1, 1), a1 + hstep, voffA);
            PG8_WAIT_L(8); PG8_BAR; PG8_WAIT_L(0); PG8_MMA(0, 0, At, B0); PG8_BAR; PG8_SCHED;
            PG8_LDB(B1, 0, 1); PG8_STAGE(PG8_SB(0, 0), b2, voffB);
            PG8_BAR; PG8_WAIT_L(0); PG8_MMA(0, 1, At, B1); PG8_BAR;
            PG8_LDA(At, 0, 1); PG8_STAGE(PG8_SA(0, 0), a2, voffA);
            PG8_BAR; PG8_WAIT_L(0); PG8_MMA(1, 0, At, B0); PG8_BAR; PG8_SCHED;
            PG8_STAGE(PG8_SB(0, 1), b2 + hstep, voffB);
            PG8_WAIT_V(6); PG8_BAR; PG8_MMA(1, 1, At, B1); PG8_BAR;
            PG8_LDB(B0, 1, 0); PG8_SCHED; PG8_LDA(At, 1, 0); PG8_STAGE(PG8_SA(0, 1), a2 + hstep, voffA);
            PG8_WAIT_L(8); PG8_BAR; PG8_WAIT_L(0); PG8_MMA(0, 0, At, B0); PG8_BAR; PG8_SCHED;
            PG8_LDB(B1, 1, 1); PG8_STAGE(PG8_SB(1, 0), b3, voffB);
            PG8_BAR; PG8_WAIT_L(0); PG8_MMA(0, 1, At, B1); PG8_BAR;
            PG8_LDA(At, 1, 1); PG8_STAGE(PG8_SA(1, 0), a3, voffA);
            PG8_BAR; PG8_WAIT_L(0); PG8_MMA(1, 0, At, B0); PG8_BAR; PG8_SCHED;
            PG8_STAGE(PG8_SB(1, 1), b3 + hstep, voffB);
            PG8_WAIT_V(6); PG8_BAR; PG8_MMA(1, 1, At, B1); PG8_BAR;
            }
        }
        if constexpr (ALIGN_EPI) { if (wr == 0) PG8_BAR; }
        E(acc, cur, wr, wc, fr, fq);
        if (!has_next) break;
#pragma unroll
        for (int a = 0; a < 2; ++a)
#pragma unroll
            for (int b = 0; b < 2; ++b)
#pragma unroll
                for (int m = 0; m < 4; ++m)
#pragma unroll
                    for (int n = 0; n < 2; ++n) acc[a][b][m][n] = (f32x4){0.f, 0.f, 0.f, 0.f};
        cur = nxt; cA = nA; cB = nB; ++ui;
        if constexpr (ALIGN_EPI) { if (wr == 1) PG8_BAR; }
    }
    PG8_WAIT_V(0);
    if constexpr (!ALIGN_EPI) { if (wr == 0) PG8_BAR; }
    PG8_BAR;
#undef PG8_SA
#undef PG8_SB
#undef PG8_STAGE
#undef PG8_LDA
#undef PG8_LDB
#undef PG8_MMA
#undef PG8_WAIT_V
#undef PG8_WAIT_L
#undef PG8_BAR
#undef PG8_SCHED
}

struct EpiProj {
    static constexpr bool PERM = true;
    bf16_t* O; int ldc;
    __device__ __forceinline__ void operator()(const f32x4 (&acc)[2][2][4][2], const Unit& u, int wr, int wc, int fr, int fq) const {
        const int row0 = u.pm * BM + wr * 64 + fr, col0 = u.pn * BM + wc * 32 + 8 * fq;
#pragma unroll
        for (int ai = 0; ai < 2; ++ai)
#pragma unroll
            for (int m = 0; m < 4; ++m) { bf16_t* rowp = O + (size_t)(row0 + ai * HALF + m * 16) * ldc + col0;
#pragma unroll
                for (int bj = 0; bj < 2; ++bj) { const f32x4 v0 = acc[ai][bj][m][0], v1 = acc[ai][bj][m][1];
                    u32x4 w; w.x = pk_bf16(v0[0], v0[1]); w.y = pk_bf16(v0[2], v0[3]); w.z = pk_bf16(v1[0], v1[1]); w.w = pk_bf16(v1[2], v1[3]);
                    *(u32x4*)(rowp + bj * HALF) = w; } }
    }
};
}

__device__ __forceinline__ int map_win(int n) {
    if (n < 8192) return n;
    if (n < 13312) return n + 8;
    if (n < 15360) return n + 56;
    if (n < 15368) return n - 15360 + 8192;
    if (n < 15416) return n - 15368 + 13320;
    return -1;
}
template <bool WIN>
__device__ void transpose_cvt(const float* __restrict__ src, int src_ld, bf16_t* __restrict__ dst, int K, int ntn) {
    const int tid = threadIdx.x, lane = tid & 63, n4 = (lane & 15) * 4, k8 = (lane >> 4) * 8;
    const int nkt = K / 32, total = ntn * nkt, gw = blockIdx.x * 8 + (tid >> 6), nw = gridDim.x * 8;
    for (int it = gw; it < total; it += nw) {
        const int tn = it / nkt, tk = it - tn * nkt, n = tn * 64 + n4;
        const int sc = WIN ? map_win(n) : n;
        f32x4 v[8];
#pragma unroll
        for (int j = 0; j < 8; ++j) v[j] = (sc >= 0) ? *(const f32x4*)(src + (size_t)(tk * 32 + k8 + j) * src_ld + sc) : (f32x4){0.f, 0.f, 0.f, 0.f};
#pragma unroll
        for (int c = 0; c < 4; ++c) { u32x4 w; w.x = pk_bf16(v[0][c], v[1][c]); w.y = pk_bf16(v[2][c], v[3][c]); w.z = pk_bf16(v[4][c], v[5][c]); w.w = pk_bf16(v[6][c], v[7][c]);
            *(u32x4*)(dst + (size_t)(n + c) * K + tk * 32 + k8) = w; }
    }
}

__device__ void phase0(const Args& a, LAS unsigned char* lds) {
    const int tid = threadIdx.x, lane = tid & 63;
    unsigned char* ws = a.ws;
    {
        const int gw = ((tid >> 6) == 0) ? (int)blockIdx.x : 256;
        if (gw < 256) { const int kv = gw >> 7, e = gw & 127; const float* pos = kv ? a.in[10] : a.in[7]; const float* w1 = kv ? a.in[11] : a.in[8];
            float sacc = 0.f;
#pragma unroll 8
            for (int k = lane; k < 4096; k += 64) sacc += pos[k] * w1[(size_t)k * 128 + e];
            sacc = wave_sum(sacc);
            if (lane == 0) ((float*)(ws + WS_PB))[gw] = sacc; }
    }
    {
        const float* x = a.in[0]; const float* gain = a.in[1]; bf16_t* HB = (bf16_t*)(ws + WS_HB);
        const int gw = blockIdx.x * 8 + (tid >> 6), nw = gridDim.x * 8;
        for (int row = gw; row < MROWS; row += nw) {
            const f32x4* xr = (const f32x4*)(x + (size_t)row * D);
            f32x4 v[16]; float ss = 0.f;
#pragma unroll
            for (int i = 0; i < 16; ++i) { v[i] = xr[lane + 64 * i]; ss += (v[i][0] * v[i][0] + v[i][1] * v[i][1]) + (v[i][2] * v[i][2] + v[i][3] * v[i][3]); }
            ss = wave_sum(ss);
            const float rstd = 1.0f / sqrtf(ss * (1.0f / D) + 1e-6f);
#pragma unroll
            for (int i = 0; i < 16; ++i) { const f32x4 g = ((const f32x4*)gain)[lane + 64 * i];
                u32x2 w; w.x = pk_bf16(v[i][0] * rstd * g[0], v[i][1] * rstd * g[1]); w.y = pk_bf16(v[i][2] * rstd * g[2], v[i][3] * rstd * g[3]);
                *(u32x2*)(HB + (size_t)row * D + (lane + 64 * i) * 4) = w; }
        }
    }
    transpose_cvt<true>(a.in[2], W_IN_COLS, (bf16_t*)(ws + WS_WIN), D, NWIN / 64);
    transpose_cvt<false>(a.in[14], D, (bf16_t*)(ws + WS_WOUT), D, D / 64);
    transpose_cvt<false>(a.in[8], 128, (bf16_t*)(ws + WS_W1T), 4096, 2);
    transpose_cvt<false>(a.in[11], 128, (bf16_t*)(ws + WS_W1T) + 128 * 4096, 4096, 2);
    transpose_cvt<false>(a.in[9], 128, (bf16_t*)(ws + WS_W2T), 128, 2);
    transpose_cvt<false>(a.in[12], 128, (bf16_t*)(ws + WS_W2T) + 128 * 128, 128, 2);
}

__device__ void gate_gemm(const Args& a, LAS unsigned char* lds) {
    const int tid = threadIdx.x, lane = tid & 63, l16 = lane & 15, g4 = lane >> 4, wv = tid >> 6;
    const bf16_t* HB = (const bf16_t*)(a.ws + WS_HB); const bf16_t* WG = (const bf16_t*)(a.ws + WS_WIN) + (size_t)NP * D;
    float* GATES = (float*)(a.ws + WS_GATES);
    LAS float* part = (LAS float*)lds;
    for (int rb = blockIdx.x; rb < MROWS / 64; rb += gridDim.x) {
        const bf16_t* Ap = HB + (size_t)(rb * 64 + l16) * D + wv * 512 + g4 * 8;
        const bf16_t* Bp = WG + (size_t)l16 * D + wv * 512 + g4 * 8;
        f32x4 acc[4][4];
#pragma unroll
        for (int mt = 0; mt < 4; ++mt)
#pragma unroll
            for (int nt = 0; nt < 4; ++nt) acc[mt][nt] = (f32x4){0.f, 0.f, 0.f, 0.f};
#pragma unroll 2
        for (int ks = 0; ks < 16; ++ks) {
            bf16x8 af[4], bfr[4];
#pragma unroll
            for (int mt = 0; mt < 4; ++mt) af[mt] = *(const bf16x8*)(Ap + (size_t)mt * 16 * D + ks * 32);
#pragma unroll
            for (int nt = 0; nt < 4; ++nt) bfr[nt] = *(const bf16x8*)(Bp + (size_t)nt * 16 * D + ks * 32);
#pragma unroll
            for (int mt = 0; mt < 4; ++mt)
#pragma unroll
                for (int nt = 0; nt < 4; ++nt) acc[mt][nt] = mfma16(af[mt], bfr[nt], acc[mt][nt]);
        }
#pragma unroll
        for (int mt = 0; mt < 4; ++mt)
#pragma unroll
            for (int nt = 0; nt < 4; ++nt)
#pragma unroll
                for (int r = 0; r < 4; ++r) part[(wv * 64 + 16 * mt + 4 * g4 + r) * 68 + 16 * nt + l16] = acc[mt][nt][r];
        __syncthreads();
#pragma unroll
        for (int i = 0; i < 8; ++i) { const int idx = tid + 512 * i, row = idx >> 6, col = idx & 63; float sum = 0.f;
#pragma unroll
            for (int w8 = 0; w8 < 8; ++w8) sum += part[(w8 * 64 + row) * 68 + col];
            GATES[(size_t)(rb * 64 + row) * 64 + col] = sum; }
        __syncthreads();
    }
}

__device__ void phase2(const Args& a, LAS unsigned char* lds) {
    const int tid = threadIdx.x, lane = tid & 63, wv = tid >> 6, l16 = lane & 15, g4 = lane >> 4;
    unsigned char* ws = a.ws;
    const bf16_t* PROJ = (const bf16_t*)(ws + WS_PROJ);
    {
        const float* wconv = a.in[3]; bf16_t* QKC = (bf16_t*)(ws + WS_QKC); bf16_t* KT = (bf16_t*)(ws + WS_KT);
        LAS bf16_t* tl = (LAS bf16_t*)lds;
        for (int idx = blockIdx.x; idx < 4096; idx += gridDim.x) {
            const int cb = (idx + (idx >> 8)) & 15, rb = idx >> 4, row0 = rb * 64, t = tid >> 3, c16 = (tid & 7) * 16, ch = cb * 128 + c16;
            const int tin = (row0 & (T - 1)) + t;
            const bf16_t* src = PROJ + (size_t)(row0 + t) * NP + ch;
            float y[16];
#pragma unroll
            for (int e = 0; e < 16; ++e) y[e] = 0.f;
#pragma unroll
            for (int j = 0; j < 4; ++j) {
                if (tin - 3 + j >= 0) {
                    const u32x4 ua = *(const u32x4*)(src - (size_t)(3 - j) * NP), ub = *(const u32x4*)(src - (size_t)(3 - j) * NP + 8);
                    const float* wp = wconv + j * 2048 + ch;
                    const f32x4 w0 = *(const f32x4*)wp, w1 = *(const f32x4*)(wp + 4), w2 = *(const f32x4*)(wp + 8), w3 = *(const f32x4*)(wp + 12);
                    y[0] += w0[0] * bflo(ua[0]); y[1] += w0[1] * bfhi(ua[0]); y[2] += w0[2] * bflo(ua[1]); y[3] += w0[3] * bfhi(ua[1]);
                    y[4] += w1[0] * bflo(ua[2]); y[5] += w1[1] * bfhi(ua[2]); y[6] += w1[2] * bflo(ua[3]); y[7] += w1[3] * bfhi(ua[3]);
                    y[8] += w2[0] * bflo(ub[0]); y[9] += w2[1] * bfhi(ub[0]); y[10] += w2[2] * bflo(ub[1]); y[11] += w2[3] * bfhi(ub[1]);
                    y[12] += w3[0] * bflo(ub[2]); y[13] += w3[1] * bfhi(ub[2]); y[14] += w3[2] * bflo(ub[3]); y[15] += w3[3] * bfhi(ub[3]);
                }
            }
            const float osc = (cb >= 8) ? 0.0625f : 1.0f;
#pragma unroll
            for (int e = 0; e < 16; ++e) y[e] = siluf(y[e]) * osc;
            u32x4 o0, o1; o0.x = pk_bf16(y[0], y[1]); o0.y = pk_bf16(y[2], y[3]); o0.z = pk_bf16(y[4], y[5]); o0.w = pk_bf16(y[6], y[7]);
            o1.x = pk_bf16(y[8], y[9]); o1.y = pk_bf16(y[10], y[11]); o1.z = pk_bf16(y[12], y[13]); o1.w = pk_bf16(y[14], y[15]);
            bf16_t* dq = QKC + (size_t)(row0 + t) * 2048 + ch;
            *(u32x4*)dq = o0; *(u32x4*)(dq + 8) = o1;
            if (cb >= 8) {
                *(LAS u32x4*)(tl + t * 136 + c16) = o0; *(LAS u32x4*)(tl + t * 136 + c16 + 8) = o1;
                __syncthreads();
                const int d = tid >> 2, t16 = (tid & 3) * 16; unsigned e[16];
#pragma unroll
                for (int j = 0; j < 16; ++j) e[j] = tl[(t16 + j) * 136 + d];
                u32x4 w0, w1; w0.x = e[0] | (e[1] << 16); w0.y = e[2] | (e[3] << 16); w0.z = e[4] | (e[5] << 16); w0.w = e[6] | (e[7] << 16);
                w1.x = e[8] | (e[9] << 16); w1.y = e[10] | (e[11] << 16); w1.z = e[12] | (e[13] << 16); w1.w = e[14] | (e[15] << 16);
                bf16_t* dst = KT + ((size_t)(row0 >> 12) * 1024 + (cb - 8) * 128 + d) * T + (row0 & (T - 1)) + t16;
                *(u32x4*)dst = w0; *(u32x4*)(dst + 8) = w1;
                __syncthreads();
            }
        }
    }
    {
        LAS bf16_t* tl = (LAS bf16_t*)lds;
        for (int idx = blockIdx.x; idx < 2048; idx += gridDim.x) {
            const bf16_t* src; bf16_t* dst;
            if (idx < 2048) { const int which = idx >> 10, bg = (idx >> 6) & 15, tt = idx & 63, b = bg >> 2, g = bg & 3;
                src = PROJ + (size_t)(b * T + tt * 64) * NP + (which ? C_WV : C_SV) + g * 128;
                dst = (bf16_t*)(ws + (which ? WS_WVT : WS_SVT)) + (size_t)bg * 128 * T + tt * 64; }
#pragma unroll
            for (int i = 0; i < 2; ++i) { const int p = tid + 512 * i, t = p >> 4, d8 = (p & 15) * 8;
                *(LAS u32x4*)(tl + t * 136 + d8) = *(const u32x4*)(src + (size_t)t * NP + d8); }
            __syncthreads();
            { const int d = tid >> 2, t16 = (tid & 3) * 16; unsigned e[16];
#pragma unroll
              for (int j = 0; j < 16; ++j) e[j] = tl[(t16 + j) * 136 + d];
              u32x4 w0, w1; w0.x = e[0] | (e[1] << 16); w0.y = e[2] | (e[3] << 16); w0.z = e[4] | (e[5] << 16); w0.w = e[6] | (e[7] << 16);
              w1.x = e[8] | (e[9] << 16); w1.y = e[10] | (e[11] << 16); w1.z = e[12] | (e[13] << 16); w1.w = e[14] | (e[15] << 16);
              *(u32x4*)(dst + (size_t)d * T + t16) = w0; *(u32x4*)(dst + (size_t)d * T + t16 + 8) = w1; }
            __syncthreads();
        }
    }
    {
        LAS bf16_t* hid = (LAS bf16_t*)lds;
        LAS float* part = (LAS float*)(lds + 8192);
        const float* PB = (const float*)(ws + WS_PB);
        bf16_t* KC = (bf16_t*)(ws + WS_KC); bf16_t* VCT = (bf16_t*)(ws + WS_VCT);
        for (int item = blockIdx.x; item < 512; item += gridDim.x) {
            const int kv = item >> 8, bg = (item >> 4) & 15, ng = item & 15, b = bg >> 2, g = bg & 3;
            const bf16_t* W1 = (const bf16_t*)(ws + WS_W1T) + (size_t)kv * 128 * 4096; const bf16_t* W2 = (const bf16_t*)(ws + WS_W2T) + kv * 128 * 128;
            int n = ng * 16 + l16; if (n > 254) n = 254;
            const bf16_t* Ap = PROJ + (size_t)(b * T + 16 * n + 4 * wv) * NP + (kv ? C_CV : C_CK) + g * 128 + g4 * 8;
            const bf16_t* Bp = W1 + (size_t)l16 * 4096 + (4 * wv) * 128 + g4 * 8;
            f32x4 acc8[8];
#pragma unroll
            for (int et = 0; et < 8; ++et) acc8[et] = (f32x4){0.f, 0.f, 0.f, 0.f};
#pragma unroll 2
            for (int li = 0; li < 4; ++li)
#pragma unroll
                for (int dq = 0; dq < 4; ++dq) { const bf16x8 av = *(const bf16x8*)(Ap + (size_t)li * NP + dq * 32);
#pragma unroll
                    for (int et = 0; et < 8; ++et) acc8[et] = mfma16(av, *(const bf16x8*)(Bp + (size_t)et * 16 * 4096 + li * 128 + dq * 32), acc8[et]); }
#pragma unroll
            for (int et = 0; et < 8; ++et)
#pragma unroll
                for (int r = 0; r < 4; ++r) part[(wv * 16 + 4 * g4 + r) * 132 + 16 * et + l16] = acc8[et][r];
            __syncthreads();
            {
#pragma unroll
                for (int i = 0; i < 4; ++i) { const int idx = tid + 512 * i, row = idx >> 7, e = idx & 127; float sum = 0.f;
#pragma unroll
                    for (int w8 = 0; w8 < 8; ++w8) sum += part[(w8 * 16 + row) * 132 + e];
                    hid[row * 136 + e] = f2bf(siluf(sum + PB[kv * 128 + e])); }
            }
            __syncthreads();
            f32x4 acc2 = (f32x4){0.f, 0.f, 0.f, 0.f};
#pragma unroll
            for (int ks = 0; ks < 4; ++ks) acc2 = mfma16(*(const LAS bf16x8*)(hid + l16 * 136 + ks * 32 + g4 * 8), *(const bf16x8*)(W2 + (16 * wv + l16) * 128 + ks * 32 + g4 * 8), acc2);
            const int f = 16 * wv + l16, nb = ng * 16 + 4 * g4;
            float o[4];
#pragma unroll
            for (int r = 0; r < 4; ++r) o[r] = (nb + r < 255) ? acc2[r] : 0.f;
            if (kv == 0) {
#pragma unroll
                for (int r = 0; r < 4; ++r) KC[((size_t)bg * 256 + nb + r) * 128 + f] = f2bf(o[r]);
            } else { u32x2 w; w.x = pk_bf16(o[0], o[1]); w.y = pk_bf16(o[2], o[3]); *(u32x2*)(VCT + ((size_t)bg * 128 + f) * 256 + nb) = w; }
            __syncthreads();
        }
    }
}

__device__ __forceinline__ void mlstm_item(const Args& a, LAS unsigned char* lds, int item) {
    const int tid = threadIdx.x, lane = tid & 63, w = __builtin_amdgcn_readfirstlane(tid >> 6), l16 = lane & 15, g4 = lane >> 4;
    const int bh = item >> 4, sl = item & 15, b = bh >> 2, h = bh & 3;
    unsigned char* ws = a.ws;
    const bf16_t* PROJ = (const bf16_t*)(ws + WS_PROJ); const bf16_t* QKC = (const bf16_t*)(ws + WS_QKC); const float* GATES = (const float*)(ws + WS_GATES);
    bf16_t* HM = (bf16_t*)(ws + WS_HM); float* SS = (float*)(ws + WS_SS);
    LAS bf16_t* qs = (LAS bf16_t*)lds;
    LAS bf16_t* ks = qs + 64 * 264;
    LAS bf16_t* kT = ks + 64 * 264;
    LAS bf16_t* vT = kT + 256 * 72;
    LAS bf16_t* vTw = vT + 48 * 72;
    LAS bf16_t* CT = vTw + 48 * 72;
    LAS float* sc = (LAS float*)(CT + 48 * 264);
    LAS bf16_t* Pm = ks;
    for (int i = tid; i < 48 * 264; i += NTHREADS) CT[i] = 0;
    for (int i = tid; i < 16 * 72; i += NTHREADS) { const int r = i / 72; vT[(32 + r) * 72 + (i - r * 72)] = (r == 0) ? (bf16_t)0x3F80 : (bf16_t)0; vTw[(32 + r) * 72 + (i - r * 72)] = 0; }
    f32x4 Cacc[2][3];
#pragma unroll
    for (int i = 0; i < 2; ++i)
#pragma unroll
        for (int j = 0; j < 3; ++j) Cacc[i][j] = (f32x4){0.f, 0.f, 0.f, 0.f};
    float m_st = 0.f;
    const float bi = a.in[4][h], bfg = a.in[5][h];
    u32x4 qreg[4], kreg[4], ktreg[4], vreg; float gi = 0.f, gf = 0.f;
    const bf16_t* KT = (const bf16_t*)(ws + WS_KT) + ((size_t)b * 1024 + h * 256) * T;
    vreg = (u32x4){0, 0, 0, 0};
    const size_t rowbase = (size_t)b * T;
#define ML_PREFETCH(t0_) do { \
        _Pragma("unroll") for (int i = 0; i < 4; ++i) { const int p = tid + 512 * i, l = p >> 5, c8 = (p & 31) * 8; const bf16_t* s_ = QKC + (rowbase + (t0_) + l) * 2048 + h * 256 + c8; \
            qreg[i] = *(const u32x4*)s_; kreg[i] = *(const u32x4*)(s_ + 1024); \
            ktreg[i] = *(const u32x4*)(KT + (size_t)(p >> 3) * T + (t0_) + (p & 7) * 8); } \
        if (tid < 256) { const int l = tid >> 2, c8 = (tid & 3) * 8; vreg = *(const u32x4*)(PROJ + (rowbase + (t0_) + l) * NP + C_MV + h * 512 + sl * 32 + c8); } \
        if (tid < 64) { const float* gp = GATES + (rowbase + (t0_) + tid) * 64; gi = gp[h] + bi; gf = gp[4 + h] + bfg; } } while (0)
    ML_PREFETCH(0);
    __syncthreads();
    for (int c = 0; c < 64; ++c) {
        const int t0 = c * 64;
#pragma unroll
        for (int i = 0; i < 4; ++i) { const int p = tid + 512 * i, l = p >> 5, c8 = (p & 31) * 8;
            *(LAS u32x4*)(qs + l * 264 + c8) = qreg[i]; *(LAS u32x4*)(ks + l * 264 + c8) = kreg[i];
            *(LAS u32x4*)(kT + (p >> 3) * 72 + (p & 7) * 8) = ktreg[i]; }
        if (tid < 256) { const int l = tid >> 2, c8 = (tid & 3) * 8;
#pragma unroll
            for (int j = 0; j < 4; ++j) { vT[(c8 + 2 * j) * 72 + l] = (bf16_t)(vreg[j] & 0xffffu); vT[(c8 + 2 * j + 1) * 72 + l] = (bf16_t)(vreg[j] >> 16); } }
        if (w == 0) {
            const float lf = fminf(gf, 0.f) - log1pf(__expf(-fabsf(gf)));
            float bc = lf;
#pragma unroll
            for (int o = 1; o < 64; o <<= 1) { const float t = __shfl_up(bc, o); if (lane >= o) bc += t; }
            const float av = gi - bc; float pm = av;
#pragma unroll
            for (int o = 1; o < 64; o <<= 1) { const float t = __shfl_up(pm, o); if (lane >= o) pm = fmaxf(pm, t); }
            const float gtot = __shfl(bc, 63);
            const float mrow = fmaxf(m_st, pm), mr63 = __shfl(mrow, 63);
            sc[lane] = av; sc[64 + lane] = mrow; sc[128 + lane] = __expf(m_st - mrow); sc[192 + lane] = __expf(-(bc + mrow)); sc[256 + lane] = __expf(av - mr63);
            if (lane == 0) sc[320] = __expf(m_st - mr63);
            m_st = gtot + mr63;
        }
        if (c + 1 < 64) ML_PREFETCH(t0 + 64);
        __syncthreads();
        const int mt = w & 3, nq = w >> 2;
        unsigned ogr[4];
#pragma unroll
        for (int r = 0; r < 4; ++r) ogr[r] = PROJ[(rowbase + t0 + 16 * mt + 4 * g4 + r) * NP + C_MO + h * 512 + sl * 32 + 16 * nq + l16];
        f32x4 s0 = (f32x4){0.f, 0.f, 0.f, 0.f}, s1 = s0, ci0 = s0, ci2 = s0;
        {
            const LAS bf16_t* ap = qs + (16 * mt + l16) * 264 + g4 * 8;
            const LAS bf16_t* b0p = ks + (16 * (2 * nq) + l16) * 264 + g4 * 8;
            const LAS bf16_t* b1p = b0p + 16 * 264;
            const LAS bf16_t* c0p = CT + (16 * nq + l16) * 264 + g4 * 8;
            const LAS bf16_t* c2p = CT + (32 + l16) * 264 + g4 * 8;
            const bool do0 = (2 * nq <= mt), do1 = (2 * nq + 1 <= mt);
#pragma unroll
            for (int kq = 0; kq < 8; ++kq) {
                const bf16x8 av = *(const LAS bf16x8*)(ap + kq * 32);
                if (do0) s0 = mfma16(av, *(const LAS bf16x8*)(b0p + kq * 32), s0);
                if (do1) s1 = mfma16(av, *(const LAS bf16x8*)(b1p + kq * 32), s1);
                ci0 = mfma16(av, *(const LAS bf16x8*)(c0p + kq * 32), ci0);
                ci2 = mfma16(av, *(const LAS bf16x8*)(c2p + kq * 32), ci2);
            }
        }
        __syncthreads();
        {
#pragma unroll
            for (int r = 0; r < 4; ++r) { const int l = 16 * mt + 4 * g4 + r; const float mr = sc[64 + l];
                { const int s = 16 * (2 * nq) + l16; const float pv = (s <= l) ? s0[r] * __expf(sc[s] - mr) : 0.f; Pm[l * 72 + s] = f2bf(pv); }
                { const int s = 16 * (2 * nq + 1) + l16; const float pv = (s <= l) ? s1[r] * __expf(sc[s] - mr) : 0.f; Pm[l * 72 + s] = f2bf(pv); } }
#pragma unroll
            for (int i = 0; i < 5; ++i) { const int idx = tid + 512 * i; if (idx < 33 * 64) { const int row = idx >> 6, s = idx & 63; const float wt = sc[256 + s];
                vTw[row * 72 + s] = f2bf(row < 32 ? bf2f(vT[row * 72 + s]) * wt : wt); } }
        }
        __syncthreads();
        {
            f32x4 n0 = (f32x4){0.f, 0.f, 0.f, 0.f}, n2 = n0;
#pragma unroll
            for (int kq = 0; kq < 2; ++kq) { const bf16x8 av = *(const LAS bf16x8*)(Pm + (16 * mt + l16) * 72 + kq * 32 + g4 * 8);
                n0 = mfma16(av, *(const LAS bf16x8*)(vT + (16 * nq + l16) * 72 + kq * 32 + g4 * 8), n0);
                n2 = mfma16(av, *(const LAS bf16x8*)(vT + (32 + l16) * 72 + kq * 32 + g4 * 8), n2); }
            const int col = h * 512 + sl * 32 + 16 * nq + l16;
#pragma unroll
            for (int r = 0; r < 4; ++r) { const int l = 16 * mt + 4 * g4 + r; const float il = sc[128 + l];
                const float num = n0[r] + il * ci0[r]; float qn = n2[r] + il * ci2[r]; qn = __shfl(qn, lane & 48);
                const float den = fmaxf(fabsf(qn), sc[192 + l]);
                const size_t row = rowbase + t0 + l;
                const float og = sigm(bf2f(ogr[r]));
                const bf16_t hb = f2bf(og * num / den); HM[row * 2048 + col] = hb;
                float sq = bf2f(hb); sq *= sq;
                sq += __shfl_xor(sq, 1); sq += __shfl_xor(sq, 2); sq += __shfl_xor(sq, 4); sq += __shfl_xor(sq, 8);
                if (l16 == 0) SS[(row * 4 + h) * 32 + sl * 2 + nq] = sq; }
            const float keep = sc[320];
#pragma unroll
            for (int m2 = 0; m2 < 2; ++m2) {
#pragma unroll
                for (int j = 0; j < 3; ++j) Cacc[m2][j] *= keep;
#pragma unroll
                for (int kq = 0; kq < 2; ++kq) { const bf16x8 av = *(const LAS bf16x8*)(kT + (32 * w + 16 * m2 + l16) * 72 + kq * 32 + g4 * 8);
#pragma unroll
                    for (int j = 0; j < 3; ++j) Cacc[m2][j] = mfma16(av, *(const LAS bf16x8*)(vTw + (16 * j + l16) * 72 + kq * 32 + g4 * 8), Cacc[m2][j]); }
#pragma unroll
                for (int j = 0; j < 3; ++j) { u32x2 wv2; wv2.x = pk_bf16(Cacc[m2][j][0], Cacc[m2][j][1]); wv2.y = pk_bf16(Cacc[m2][j][2], Cacc[m2][j][3]);
                    *(LAS u32x2*)(CT + (16 * j + l16) * 264 + 32 * w + 16 * m2 + 4 * g4) = wv2; }
            }
        }
        __syncthreads();
    }
#undef ML_PREFETCH
}

struct TileDesc { const bf16_t* K; size_t kstr; const bf16_t* V; size_t vstr; int kp0, kstep, wlim, selj; };

constexpr float NEGL = -1e30f;
constexpr float QK_SC = 0.08838834764831845f * 1.4426950408889634f;

constexpr int TBN = 1088;
template <int MODE, int NTS>
__device__ __forceinline__ void nsa_tile(const LAS bf16_t* Kt, const LAS bf16_t* Vt, const LAS float* TB, const TileDesc& td, const bf16x8 (&qf)[2][4],
                                         const int (&tq)[2], const LAS unsigned long long* selm, int hh, int l16, int g4,
                                         f32x4 (&O)[8][2], float (&mrun)[2], float (&lrun)[2], const float (&invl)[2],
                                         LAS float* PA, LAS float* PBv, int w, int kt64, int t0, const bool MASKED) {
    const bool far = (t0 - (td.kp0 + 63 * td.kstep)) >= 790;
    const float bfar = TB[(1023 + 64) * 4 + hh];
    const bool alw0 = (td.selj < 0) || ((selm[0] >> td.selj) & 1ull), alw1 = (td.selj < 0) || ((selm[4] >> td.selj) & 1ull);
    constexpr bool any0 = (NTS & 1) != 0, any1 = (NTS & 2) != 0;
#pragma unroll 1
    for (int i = 0; i < 2; ++i) {
        f32x4 S[2][2];
#pragma unroll
        for (int mm = 0; mm < 2; ++mm) { S[mm][0] = (f32x4){0.f, 0.f, 0.f, 0.f}; S[mm][1] = S[mm][0]; }
#pragma unroll
        for (int mm = 0; mm < 2; ++mm)
#pragma unroll
            for (int kq = 0; kq < 4; ++kq) { const bf16x8 av = *(const LAS bf16x8*)(Kt + (32 * i + 16 * mm + l16) * 136 + kq * 32 + g4 * 8);
                if (any0) S[mm][0] = mfma16(av, qf[0][kq], S[mm][0]);
                if (any1) S[mm][1] = mfma16(av, qf[1][kq], S[mm][1]); }
#pragma unroll
        for (int nt = 0; nt < 2; ++nt) {
            const bool allowed = nt ? alw1 : alw0;
            if (!(nt ? any1 : any0)) continue;
            float mx = NEGL;
            if (MASKED) {
#pragma unroll
                for (int mm = 0; mm < 2; ++mm)
#pragma unroll
                    for (int r = 0; r < 4; ++r) {
                        const int kk = 32 * i + 16 * mm + 4 * g4 + r, dist = tq[nt] - (td.kp0 + td.kstep * kk);
                        const bool ok = allowed && dist >= 0 && dist < td.wlim;
                        float bias = bfar;
                        if (!far) { int di = dist < -64 ? -64 : dist; di = di > 1023 ? 1023 : di; bias = TB[(di + 64) * 4 + hh]; }
                        const float lg = ok ? S[mm][nt][r] * QK_SC + bias : NEGL;
                        S[mm][nt][r] = lg; mx = fmaxf(mx, lg);
                    }
            } else {
                if (far) {
#pragma unroll
                    for (int mm = 0; mm < 2; ++mm)
#pragma unroll
                        for (int r = 0; r < 4; ++r) { const float lg = S[mm][nt][r] * QK_SC + bfar; S[mm][nt][r] = lg; mx = fmaxf(mx, lg); }
                } else {
                    const LAS float* tp = TB + ((tq[nt] - td.kp0 - 4 * g4 + 64 - 32 * i - 19) * 4 + hh);
#pragma unroll
                    for (int mm = 0; mm < 2; ++mm)
#pragma unroll
                        for (int r = 0; r < 4; ++r) { const float lg = S[mm][nt][r] * QK_SC + tp[(19 - 16 * mm - r) * 4]; S[mm][nt][r] = lg; mx = fmaxf(mx, lg); }
                }
                if (!allowed) mx = NEGL;
            }
            if (MODE != 1) {
                mx = colgroup_max(mx);
                const float mnew = fmaxf(mrun[nt], mx), alpha = __builtin_amdgcn_exp2f(mrun[nt] - mnew);
                mrun[nt] = mnew; float ps = 0.f;
#pragma unroll
                for (int mm = 0; mm < 2; ++mm)
#pragma unroll
                    for (int r = 0; r < 4; ++r) { const float lg = S[mm][nt][r];
                        const float p = MASKED ? ((lg <= -1e29f) ? 0.f : __builtin_amdgcn_exp2f(lg - mnew)) : (allowed ? __builtin_amdgcn_exp2f(lg - mnew) : 0.f);
                        S[mm][nt][r] = p; ps += p; }
                lrun[nt] = lrun[nt] * alpha + ps;
                if (MODE == 2) {
                    if (__builtin_amdgcn_ballot_w64(alpha != 1.0f) != 0ull) {
#pragma unroll
                        for (int dt = 0; dt < 8; ++dt) O[dt][nt] *= alpha;
                    }
                }
            } else {
                const float mfix = mrun[nt], il = invl[nt];
#pragma unroll
                for (int mm = 0; mm < 2; ++mm) {
#pragma unroll
                    for (int r = 0; r < 4; ++r) { const float lg = S[mm][nt][r]; S[mm][nt][r] = (lg <= -1e29f) ? 0.f : __builtin_amdgcn_exp2f(lg - mfix) * il; }
                    float pa = (S[mm][nt][0] + S[mm][nt][1]) + (S[mm][nt][2] + 0.5f * S[mm][nt][3]), pb = 0.5f * S[mm][nt][3];
                    pa += __shfl_xor(pa, 1); pa += __shfl_xor(pa, 2); pb += __shfl_xor(pb, 1); pb += __shfl_xor(pb, 2);
                    if ((l16 & 3) == 0) { const int tok = 8 * w + 4 * nt + (l16 >> 2), j = 16 * kt64 + 4 * (2 * i + mm) + g4; PA[tok * 65 + j] = pa; if (j + 1 < 64) PBv[tok * 65 + j + 1] = pb; }
                }
            }
        }
        if (MODE != 0) {
            bf16x8 pb[2];
#pragma unroll
            for (int nt = 0; nt < 2; ++nt) { u32x4 u; u.x = pk_bf16(S[0][nt][0], S[0][nt][1]); u.y = pk_bf16(S[0][nt][2], S[0][nt][3]);
                u.z = pk_bf16(S[1][nt][0], S[1][nt][1]); u.w = pk_bf16(S[1][nt][2], S[1][nt][3]); pb[nt] = as_bf16x8(u); }
#pragma unroll
            for (int dt = 0; dt < 8; ++dt) { const LAS bf16_t* vp = Vt + (16 * dt + l16) * 72 + 32 * i + 4 * g4;
                const u32x2 lo = *(const LAS u32x2*)vp, hi = *(const LAS u32x2*)(vp + 16);
                const bf16x8 av = as_bf16x8((u32x4){lo.x, lo.y, hi.x, hi.y});
                if (any0) O[dt][0] = mfma16(av, pb[0], O[dt][0]);
                if (any1) O[dt][1] = mfma16(av, pb[1], O[dt][1]); }
        }
    }
}

__device__ __forceinline__ void nsa_load(const TileDesc& td, int tid, u32x4 (&kr)[2], u32x4 (&vr)[2]) {
#pragma unroll
    for (int i = 0; i < 2; ++i) { const int p = tid + 512 * i;
        kr[i] = *(const u32x4*)(td.K + (size_t)(p >> 4) * td.kstr + (p & 15) * 8);
        vr[i] = *(const u32x4*)(td.V + (size_t)(p >> 3) * td.vstr + (p & 7) * 8); }
}
__device__ __forceinline__ void nsa_store(LAS bf16_t* Kb, LAS bf16_t* Vb, int tid, const u32x4 (&kr)[2], const u32x4 (&vr)[2]) {
#pragma unroll
    for (int i = 0; i < 2; ++i) { const int p = tid + 512 * i;
        *(LAS u32x4*)(Kb + (p >> 4) * 136 + (p & 15) * 8) = kr[i];
        *(LAS u32x4*)(Vb + (p >> 3) * 72 + (p & 7) * 8) = vr[i]; }
}

__device__ __forceinline__ void nsa_unit(const Args& a, LAS unsigned char* lds, int bg, int qb) {
    const int tid = threadIdx.x, lane = tid & 63, w = __builtin_amdgcn_readfirstlane(tid >> 6), l16 = lane & 15, g4 = lane >> 4;
    const int b = bg >> 2, g = bg & 3, t0 = qb * 64, hh = l16 & 3;
    unsigned char* ws = a.ws;
    const bf16_t* PROJ = (const bf16_t*)(ws + WS_PROJ); const float* GATES = (const float*)(ws + WS_GATES);
    LAS bf16_t* Kb0 = (LAS bf16_t*)lds;
    LAS bf16_t* Vb0 = Kb0 + 2 * 64 * 136;
    LAS float* TB = (LAS float*)(Vb0 + 2 * 128 * 72);
    LAS float* PA = TB + 4 * TBN;
    LAS float* PBv = PA + 64 * 65;
    LAS unsigned long long* SELM = (LAS unsigned long long*)(PBv + 64 * 65);
    LAS unsigned long long* UNI = SELM + 64;
    {
        const float* rel = a.in[13];
        for (int i = tid; i < 4 * TBN; i += NTHREADS) { const int h = i & 3, d = (i >> 2) - 64; int bk = d < 0 ? 0 : d;
            if (d >= 16) { bk = 16 + (d >= 21) + (d >= 27) + (d >= 35) + (d >= 46) + (d >= 59) + (d >= 77) + (d >= 99) + (d >= 128) + (d >= 166) + (d >= 216) + (d >= 280) + (d >= 363) + (d >= 470) + (d >= 609) + (d >= 790); }
            TB[i] = rel[bk * 16 + g * 4 + h] * 1.4426950408889634f; }
        for (int i = tid; i < 2 * 64 * 65; i += NTHREADS) PA[i] = 0.f;
    }
    int tq[2]; bf16x8 qf[2][4];
#pragma unroll
    for (int nt = 0; nt < 2; ++nt) { tq[nt] = t0 + 8 * w + 4 * nt + (l16 >> 2); const size_t row = (size_t)b * T + tq[nt];
        const bf16_t* qp = PROJ + row * NP + C_AQ + (g * 4 + hh) * 128 + g4 * 8;
#pragma unroll
        for (int kq = 0; kq < 4; ++kq) qf[nt][kq] = *(const bf16x8*)(qp + kq * 32);
 }
    f32x4 O[8][2];
    float mrun[2], lrun[2], invl[2] = {0.f, 0.f};
    const LAS unsigned long long* selm = SELM + 8 * w + (l16 >> 2);
    u32x4 kr[2], vr[2];
    TileDesc td;
#define O_ZERO() do { _Pragma("unroll") for (int dt = 0; dt < 8; ++dt) { O[dt][0] = (f32x4){0.f, 0.f, 0.f, 0.f}; O[dt][1] = O[dt][0]; } } while (0)
    const int ncmp = ((t0 + 32) >> 10) + 1 > 4 ? 4 : ((t0 + 32) >> 10) + 1;
    const bf16_t* KC = (const bf16_t*)(ws + WS_KC) + (size_t)bg * 256 * 128; const bf16_t* VCT = (const bf16_t*)(ws + WS_VCT) + (size_t)bg * 128 * 256;
    td.kstr = 128; td.vstr = 256; td.kstep = 16; td.wlim = 1 << 30; td.selj = -1;
    mrun[0] = mrun[1] = NEGL; lrun[0] = lrun[1] = 0.f;
    __syncthreads();
    for (int pass = 0; pass < 2; ++pass) {
        if (pass == 1) {
#pragma unroll
            for (int nt = 0; nt < 2; ++nt) { float l = lrun[nt]; l += __shfl_xor(l, 16); l += __shfl_xor(l, 32); invl[nt] = l > 0.f ? 1.0f / l : 0.f; }
            O_ZERO();
        }
        for (int kt = 0; kt < ncmp; ++kt) {
            td.K = KC + (size_t)kt * 64 * 128; td.V = VCT + kt * 64; td.kp0 = 1024 * kt + 31;
            nsa_load(td, tid, kr, vr); nsa_store(Kb0, Vb0, tid, kr, vr);
            __syncthreads();
            if (pass == 0) nsa_tile<0, 3>(Kb0, Vb0, TB, td, qf, tq, selm, hh, l16, g4, O, mrun, lrun, invl, PA, PBv, w, kt, t0, true);
            else nsa_tile<1, 3>(Kb0, Vb0, TB, td, qf, tq, selm, hh, l16, g4, O, mrun, lrun, invl, PA, PBv, w, kt, t0, true);
            __syncthreads();
        }
    }
    bf16_t* MIXA = (bf16_t*)(ws + WS_HB) + 2048 + (g * 4 + hh) * 128 + 4 * g4;
#pragma unroll
    for (int nt = 0; nt < 2; ++nt) { const float c = sigm(GATES[((size_t)b * T + tq[nt]) * 64 + 8 + (g * 4 + hh) * 3]); bf16_t* mp = MIXA + ((size_t)b * T + tq[nt]) * D;
#pragma unroll
        for (int dt = 0; dt < 8; ++dt) { u32x2 o; o.x = pk_bf16(O[dt][nt][0] * c, O[dt][nt][1] * c); o.y = pk_bf16(O[dt][nt][2] * c, O[dt][nt][3] * c); *(u32x2*)(mp + 16 * dt) = o; } }
    {
        unsigned long long uni = 0ull;
        const unsigned long long validmask = (qb >= 63) ? ~0ull : ((1ull << (qb + 1)) - 1ull);
        for (int ti = 0; ti < 8; ++ti) { const int tok = 8 * w + ti, j = lane;
            const bool valid = j <= qb, forced = (j == 0) || (j == qb) || (j == qb - 1);
            const float score = (PA[tok * 65 + j] + PBv[tok * 65 + j]) + (forced ? 1000.f : 0.f);
            const unsigned key = valid ? __float_as_uint(score) : 0u;
            unsigned thr = 0u;
#pragma unroll
            for (int bit = 31; bit >= 0; --bit) { const unsigned cand = thr | (1u << bit); if (__popcll(__ballot(key >= cand)) >= 16) thr = cand; }
            unsigned long long sel = __ballot(key > thr), eq = __ballot(key == thr);
            for (int need = 16 - __popcll(sel); need > 0; --need) { const unsigned long long b = eq & (0ull - eq); sel |= b; eq ^= b; }
            const unsigned long long msk = sel & validmask;
            if (lane == 0) SELM[tok] = msk;
            uni |= msk; }
        if (lane == 0) UNI[w] = uni;
    }
    __syncthreads();
    unsigned long long uni = 0ull;
#pragma unroll
    for (int i = 0; i < 8; ++i) uni |= UNI[i];
    for (int br = 1; br < 3; ++br) {
        unsigned long long rem;
        if (br == 1) { rem = uni; td.kstr = NP; td.vstr = T; td.kstep = 1; td.wlim = 1 << 30; }
        else { const int lo = qb >= 8 ? 0 : 8 - qb; rem = (0x1ffull >> lo) << lo; td.kstr = NP; td.vstr = T; td.kstep = 1; td.wlim = 512; td.selj = -1; }
        const bf16_t* Kbase = PROJ + (size_t)b * T * NP + (br == 1 ? C_SK : C_WK) + g * 128;
        const bf16_t* Vbase = (const bf16_t*)(ws + (br == 1 ? WS_SVT : WS_WVT)) + (size_t)bg * 128 * T;
        mrun[0] = mrun[1] = NEGL; lrun[0] = lrun[1] = 0.f; O_ZERO();
        int j = __builtin_ctzll(rem); rem &= rem - 1;
        { const int s0 = (br == 1) ? 64 * j : t0 - 512 + 64 * j; td.K = Kbase + (size_t)s0 * NP; td.V = Vbase + s0; td.kp0 = s0; if (br == 1) td.selj = j; }
        nsa_load(td, tid, kr, vr); nsa_store(Kb0, Vb0, tid, kr, vr);
        __syncthreads();
        int buf = 0;
        for (;;) {
            const int jn = rem ? __builtin_ctzll(rem) : -1;
            TileDesc tn = td;
            if (jn >= 0) { const int s0 = (br == 1) ? 64 * jn : t0 - 512 + 64 * jn; tn.K = Kbase + (size_t)s0 * NP; tn.V = Vbase + s0; tn.kp0 = s0; if (br == 1) tn.selj = jn; nsa_load(tn, tid, kr, vr); }
            const bool msk = (br == 1) ? (j == qb) : (j == 0 || j == 8);
            {
                const bool a0 = (td.selj < 0) || ((selm[0] >> td.selj) & 1ull), a1 = (td.selj < 0) || ((selm[4] >> td.selj) & 1ull);
                const bool any0 = __builtin_amdgcn_ballot_w64(a0) != 0ull, any1 = __builtin_amdgcn_ballot_w64(a1) != 0ull;
                const LAS bf16_t* kb = Kb0 + buf * 64 * 136; const LAS bf16_t* vb = Vb0 + buf * 128 * 72;
                if (any0 || any1) nsa_tile<2, 3>(kb, vb, TB, td, qf, tq, selm, hh, l16, g4, O, mrun, lrun, invl, PA, PBv, w, 0, t0, msk);
            }
            if (jn >= 0) nsa_store(Kb0 + (buf ^ 1) * 64 * 136, Vb0 + (buf ^ 1) * 128 * 72, tid, kr, vr);
            __syncthreads();
            if (jn < 0) break;
            rem &= rem - 1; td = tn; buf ^= 1; j = jn;
        }
#pragma unroll
        for (int nt = 0; nt < 2; ++nt) { float l = lrun[nt]; l += __shfl_xor(l, 16); l += __shfl_xor(l, 32); const size_t row = (size_t)b * T + tq[nt]; bf16_t* mp = MIXA + row * D;
            const float gsel = sigm(GATES[row * 64 + 8 + (g * 4 + hh) * 3 + br]); const float c = l > 0.f ? gsel / l : 0.f;
#pragma unroll
            for (int dt = 0; dt < 8; ++dt) { const u32x2 prev = *(const u32x2*)(mp + 16 * dt);
                const float o0 = bflo(prev.x) + O[dt][nt][0] * c, o1 = bfhi(prev.x) + O[dt][nt][1] * c, o2 = bflo(prev.y) + O[dt][nt][2] * c, o3 = bfhi(prev.y) + O[dt][nt][3] * c;
                u32x2 o;
                if (br == 1) { o.x = pk_bf16(o0, o1); o.y = pk_bf16(o2, o3); }
                else { const u32x2 z = *(const u32x2*)(PROJ + row * NP + C_AZ + (g * 4 + hh) * 128 + 16 * dt + 4 * g4);
                    o.x = pk_bf16(o0 * siluf(bflo(z.x)), o1 * siluf(bfhi(z.x))); o.y = pk_bf16(o2 * siluf(bflo(z.y)), o3 * siluf(bfhi(z.y))); }
                *(u32x2*)(mp + 16 * dt) = o; } }
    }
    __syncthreads();
#undef O_ZERO
}

__device__ void phase4(const Args& a) {
    const int tid = threadIdx.x, lane = tid & 63;
    unsigned char* ws = a.ws;
    const bf16_t* PROJ = (const bf16_t*)(ws + WS_PROJ); const bf16_t* HM = (const bf16_t*)(ws + WS_HM); const float* SS = (const float*)(ws + WS_SS);
    bf16_t* MIX = (bf16_t*)(ws + WS_HB); const float* gain = a.in[6];
    const int gw = blockIdx.x * 8 + (tid >> 6), nw = gridDim.x * 8;
    for (int it = gw; it < MROWS * 4; it += nw) {
        const int row = it >> 2, h = it & 3, c8 = h * 512 + lane * 8;
        const u32x4 hv = *(const u32x4*)(HM + (size_t)row * 2048 + c8), zv = *(const u32x4*)(PROJ + (size_t)row * NP + C_MZ + c8);
        const float sp = SS[(size_t)it * 32 + (lane & 31)];
        float s = sp; s += __shfl_xor(s, 1); s += __shfl_xor(s, 2); s += __shfl_xor(s, 4); s += __shfl_xor(s, 8); s += __shfl_xor(s, 16);
        const float rstd = 1.0f / sqrtf(s * (1.0f / 512.f) + 1e-6f);
        const f32x4 g0 = *(const f32x4*)(gain + c8), g1 = *(const f32x4*)(gain + c8 + 4);
        u32x4 o;
        o.x = pk_bf16(bflo(hv.x) * rstd * g0[0] * siluf(bflo(zv.x)), bfhi(hv.x) * rstd * g0[1] * siluf(bfhi(zv.x)));
        o.y = pk_bf16(bflo(hv.y) * rstd * g0[2] * siluf(bflo(zv.y)), bfhi(hv.y) * rstd * g0[3] * siluf(bfhi(zv.y)));
        o.z = pk_bf16(bflo(hv.z) * rstd * g1[0] * siluf(bflo(zv.z)), bfhi(hv.z) * rstd * g1[1] * siluf(bfhi(zv.z)));
        o.w = pk_bf16(bflo(hv.w) * rstd * g1[2] * siluf(bflo(zv.w)), bfhi(hv.w) * rstd * g1[3] * siluf(bfhi(zv.w)));
        *(u32x4*)(MIX + (size_t)row * D + c8) = o;
    }
}

__device__ void phase6(const Args& a) {
    const int tid = threadIdx.x, lane = tid & 63;
    float* out = a.out; const float* x = a.in[0]; const float* gain = a.in[15];
    const int gw = blockIdx.x * 8 + (tid >> 6), nw = gridDim.x * 8;
    for (int row = gw; row < MROWS; row += nw) {
        f32x4* orow = (f32x4*)(out + (size_t)row * D); const f32x4* xr = (const f32x4*)(x + (size_t)row * D);
        const u32x2* pr = (const u32x2*)((const bf16_t*)(a.ws + WS_PROJ) + (size_t)row * D);
        f32x4 v[16]; float ss = 0.f;
#pragma unroll
        for (int i = 0; i < 16; ++i) { const u32x2 pv = pr[lane + 64 * i]; const f32x4 xv = xr[lane + 64 * i];
            v[i][0] = bflo(pv.x) + xv[0]; v[i][1] = bfhi(pv.x) + xv[1]; v[i][2] = bflo(pv.y) + xv[2]; v[i][3] = bfhi(pv.y) + xv[3];
            ss += (v[i][0] * v[i][0] + v[i][1] * v[i][1]) + (v[i][2] * v[i][2] + v[i][3] * v[i][3]); }
        ss = wave_sum(ss);
        const float rstd = 1.0f / sqrtf(ss * (1.0f / D) + 1e-6f);
#pragma unroll
        for (int i = 0; i < 16; ++i) { const f32x4 g = ((const f32x4*)gain)[lane + 64 * i]; f32x4 o;
            o[0] = v[i][0] * rstd * g[0]; o[1] = v[i][1] * rstd * g[1]; o[2] = v[i][2] * rstd * g[2]; o[3] = v[i][3] * rstd * g[3]; orow[lane + 64 * i] = o; }
    }
}

__global__ void __launch_bounds__(NTHREADS, 2) hymba_fwd(Args a) {
    extern __shared__ __attribute__((aligned(16))) unsigned char lds_raw[];
    LAS unsigned char* lds = (LAS unsigned char*)lds_raw;
    cg::grid_group grid = cg::this_grid();
    volatile LAS unsigned* xb_st = (volatile LAS unsigned*)(lds + (LDS_BYTES - 16));
    if (threadIdx.x < 4) xb_st[threadIdx.x] = 0u;
    __syncthreads();
    unsigned* xb_words = (unsigned*)(a.ws + WS_BAR);
    XcdBarrier xbar; xbar.bar = xb_words; xbar.x = 0u; xbar.st = xb_st;
    const int lo = a.ph_lo, hi = a.ph_hi;
#ifdef STAMP_SEL
    unsigned long long* stamps = (unsigned long long*)(a.ws + WS_END2);
#define STAMP(k) do { if (blockIdx.x == 0 && threadIdx.x == 0) stamps[k] = __builtin_amdgcn_s_memrealtime(); } while (0)
#else
#define STAMP(k) do { } while (0)
#endif
    STAMP(0);
#ifndef PH_MASK
#define PH_MASK 0x7f
#endif
#define IN(k) (((PH_MASK >> (k)) & 1) && lo <= (k) && (k) < hi)
#define SEAM(k) do { if ((k) + 1 < hi) { if ((k) == 0) { asm volatile("s_waitcnt vmcnt(0)" ::: "memory"); grid.sync(); xbar = xcd_barrier_post(xb_words, xb_st); } else xcd_barrier(xbar); } } while (0)
    if (IN(0)) { if (blockIdx.x == 0) for (int i = threadIdx.x; i < XCD_BAR_WORDS; i += NTHREADS) xb_words[i] = 0u;
        for (int rep = 0; rep < REP_P0; ++rep) phase0(a, lds); SEAM(0); STAMP(1); }
    if (IN(1)) { for (int rep = 0; rep < REP_P1; ++rep) {
        pg8::Gemm g{(const bf16_t*)(a.ws + WS_HB), (const bf16_t*)(a.ws + WS_WIN), MROWS, NP, D};
        pg8::StaticOrder S; S.init(MROWS, NP, gridDim.x, blockIdx.x);
        pg8::EpiProj E{(bf16_t*)(a.ws + WS_PROJ), NP};
        pg8::gemm_phase<pg8::EpiProj>(lds, g, S, E);
        gate_gemm(a, lds); }
        SEAM(1); STAMP(2);
    }
    if (IN(2)) { for (int rep = 0; rep < REP_P2; ++rep) phase2(a, lds); SEAM(2); STAMP(3); }
    if (IN(3)) {
#ifndef NO_MLSTM
        for (int rep = 0; rep < REP_ML; ++rep)
        for (int it0 = blockIdx.x; it0 < 256; it0 += gridDim.x) {
            const int item = (gridDim.x == 256) ? (((it0 & 7) * 2 + (it0 >> 7)) * 16 + ((it0 >> 3) & 15)) : it0;
            mlstm_item(a, lds, item); }
#endif
        __syncthreads();
        STAMP(4);
#ifndef NO_NSA
        for (int rep = 0; rep < REP_NSA; ++rep)
        for (int p2 = blockIdx.x * 2; p2 < 1024; p2 += gridDim.x * 2)
            for (int u = 0; u < 2; ++u) { const int p = p2 >> 1, bg = p & 15, qq = p >> 4; nsa_unit(a, lds, bg, u ? qq : 63 - qq); }
#endif
        SEAM(3); STAMP(5);
    }
    if (IN(4)) { phase4(a); SEAM(4); STAMP(6); }
    if (IN(5)) { for (int rep = 0; rep < REP_P5; ++rep) {
        pg8::Gemm g{(const bf16_t*)(a.ws + WS_HB), (const bf16_t*)(a.ws + WS_WOUT), MROWS, D, D};
        pg8::StaticOrder S; S.init(MROWS, D, gridDim.x, blockIdx.x);
        pg8::EpiProj E{(bf16_t*)(a.ws + WS_PROJ), D};
        pg8::gemm_phase<pg8::EpiProj>(lds, g, S, E); }
        SEAM(5); STAMP(7);
    }
    if (IN(6)) { phase6(a); }
#ifdef STAMP_SEL
    __builtin_amdgcn_fence(__ATOMIC_RELEASE, "agent"); grid.sync(); __builtin_amdgcn_fence(__ATOMIC_ACQUIRE, "agent");
    if (blockIdx.x == 0) { STAMP(8); __syncthreads();
        const unsigned long long k = stamps[STAMP_SEL + 1] - stamps[STAMP_SEL];
        for (unsigned long long i = threadIdx.x; i < k; i += NTHREADS) a.out[i] += 0.0625f; }
#endif
#undef IN
#undef SEAM
}

extern "C" void kernel_launch(void* const* d_in, const int* in_sizes, int n_in, void* d_out, int out_size, void* d_ws, size_t ws_size, hipStream_t stream) {
    static int grid = 0;
    if (grid == 0) {
        if (n_in != 16 || ws_size < WS_END3) { fprintf(stderr, "kernel_launch: bad inputs (n_in %d, ws %zu, need %zu)\n", n_in, ws_size, (size_t)WS_END); grid = -1; return; }
        int dev = 0, cus = 0, per_cu = 0;
        (void)hipGetDevice(&dev);
        (void)hipDeviceGetAttribute(&cus, hipDeviceAttributeMultiprocessorCount, dev);
        if (hipFuncSetAttribute((const void*)hymba_fwd, hipFuncAttributeMaxDynamicSharedMemorySize, LDS_BYTES) != hipSuccess) { fprintf(stderr, "kernel_launch: hipFuncSetAttribute failed\n"); grid = -1; return; }
        if (hipOccupancyMaxActiveBlocksPerMultiprocessor(&per_cu, (const void*)hymba_fwd, NTHREADS, LDS_BYTES) != hipSuccess || per_cu < 1) { fprintf(stderr, "kernel_launch: occupancy query says %d\n", per_cu); per_cu = 1; }
        (void)hipGetLastError();
        grid = cus * 1;
    }
    if (grid < 0) return;
    Args a{};
    for (int i = 0; i < 16; ++i) a.in[i] = (const float*)d_in[i];
    a.out = (float*)d_out; a.ws = (unsigned char*)d_ws;
#if N_LAUNCH_SPLIT
    for (int ph = 0; ph < 7; ++ph) { a.ph_lo = ph; a.ph_hi = ph + 1; hipLaunchKernelGGL(hymba_fwd, dim3(grid), dim3(NTHREADS), LDS_BYTES, stream, a); }
#else
    a.ph_lo = 0; a.ph_hi = 7;
    void* args[] = {&a};
    hipError_t e = hipLaunchCooperativeKernel((const void*)hymba_fwd, dim3(grid), dim3(NTHREADS), args, LDS_BYTES, stream);
    if (e != hipSuccess) fprintf(stderr, "cooperative launch failed: %s (grid %d)\n", hipGetErrorString(e), grid);
#endif
}
```

```cpp
#include <hip/hip_runtime.h>
#include <hip/hip_cooperative_groups.h>
#include <cstdio>
namespace cg = cooperative_groups;

#ifndef REP_P0
#define REP_P0 1
#endif
#ifndef REP_P1
#define REP_P1 1
#endif
#ifndef REP_P2
#define REP_P2 1
#endif
#ifndef REP_ML
#define REP_ML 1
#endif
#ifndef REP_NSA
#define REP_NSA 1
#endif
#ifndef REP_P5
#define REP_P5 1
#endif
#ifndef N_LAUNCH_SPLIT
#define N_LAUNCH_SPLIT 0
#endif

#define LAS __attribute__((address_space(3)))
typedef unsigned short bf16_t;
typedef short bf16x8 __attribute__((ext_vector_type(8)));
typedef short bf16x4 __attribute__((ext_vector_type(4)));
typedef float f32x4 __attribute__((ext_vector_type(4)));
typedef unsigned u32x4 __attribute__((ext_vector_type(4)));
typedef unsigned u32x2 __attribute__((ext_vector_type(2)));

constexpr int NB = 4, T = 4096, D = 4096, MROWS = NB * T;
constexpr int NP = 15360;
constexpr int NWIN = 15424;
constexpr int W_IN_COLS = 15416;
constexpr int C_MQ = 0, C_MK = 1024, C_MV = 2048, C_MO = 4096, C_MZ = 6144, C_AQ = 8192, C_CK = 10240, C_CV = 10752,
              C_SK = 11264, C_SV = 11776, C_WK = 12288, C_WV = 12800, C_AZ = 13312;
constexpr int NTHREADS = 512;
constexpr int LDS_BYTES = 147456;

#define XCD_BAR_WORDS 3456
constexpr size_t WS_HB = 0;
constexpr size_t WS_WIN = WS_HB + (size_t)MROWS * D * 2;
constexpr size_t WS_WOUT = WS_WIN + (size_t)NWIN * D * 2;
constexpr size_t WS_PROJ = WS_WOUT + (size_t)D * D * 2;
constexpr size_t WS_GATES = WS_PROJ + (size_t)MROWS * NP * 2;
constexpr size_t WS_QKC = WS_GATES + (size_t)MROWS * 64 * 4;
constexpr size_t WS_SVT = WS_QKC + (size_t)MROWS * 2048 * 2;
constexpr size_t WS_WVT = WS_SVT + (size_t)16 * 128 * 4096 * 2;
constexpr size_t WS_KC = WS_WVT + (size_t)16 * 128 * 4096 * 2;
constexpr size_t WS_VCT = WS_KC + (size_t)16 * 256 * 128 * 2;
constexpr size_t WS_W1T = WS_VCT + (size_t)16 * 256 * 128 * 2;
constexpr size_t WS_W2T = WS_W1T + (size_t)2 * 128 * 4096 * 2;
constexpr size_t WS_PB = WS_W2T + (size_t)2 * 128 * 128 * 2;
constexpr size_t WS_HM = WS_PB + 1024;
constexpr size_t WS_SS = WS_HM + (size_t)MROWS * 2048 * 2;
constexpr size_t WS_SSQ = WS_SS + (size_t)MROWS * 128 * 4;
constexpr size_t WS_END = WS_SSQ + (size_t)MROWS * 64 * 4;
constexpr size_t WS_KT = WS_END;
constexpr size_t WS_END2 = WS_KT + (size_t)4 * 1024 * T * 2;
constexpr size_t WS_BAR = WS_END2 + 256;
constexpr size_t WS_END3 = WS_BAR + (size_t)XCD_BAR_WORDS * 4;
static_assert(WS_END3 <= ((size_t)1 << 30), "workspace map must fit 1 GiB");

struct Args { const float* in[16]; float* out; unsigned char* ws; int ph_lo, ph_hi; };

__device__ __forceinline__ unsigned pk_bf16(float lo, float hi) { unsigned r; asm("v_cvt_pk_bf16_f32 %0, %1, %2" : "=v"(r) : "v"(lo), "v"(hi)); return r; }
__device__ __forceinline__ bf16_t f2bf(float f) { return (bf16_t)(pk_bf16(f, 0.f) & 0xffffu); }
__device__ __forceinline__ float bf2f(unsigned b) { return __uint_as_float(b << 16); }
__device__ __forceinline__ float bflo(unsigned w) { return __uint_as_float(w << 16); }
__device__ __forceinline__ float bfhi(unsigned w) { return __uint_as_float(w & 0xffff0000u); }
__device__ __forceinline__ float wave_sum(float v) {
#pragma unroll
    for (int o = 32; o >= 1; o >>= 1) v += __shfl_xor(v, o);
    return v;
}
__device__ __forceinline__ float colgroup_max(float x) {
    const unsigned xi = __float_as_uint(x);
    const auto r = __builtin_amdgcn_permlane32_swap(xi, xi, false, false);
    const float m1 = fmaxf(__uint_as_float(r[0]), __uint_as_float(r[1]));
    const unsigned mi = __float_as_uint(m1);
    const auto r2 = __builtin_amdgcn_permlane16_swap(mi, mi, false, false);
    return fmaxf(__uint_as_float(r2[0]), __uint_as_float(r2[1]));
}
__device__ __forceinline__ float siluf(float x) { return x / (1.f + __expf(-x)); }
__device__ __forceinline__ float sigm(float x) { return 1.f / (1.f + __expf(-x)); }
__device__ __forceinline__ f32x4 mfma16(bf16x8 a, bf16x8 b, f32x4 c) { return __builtin_amdgcn_mfma_f32_16x16x32_bf16(a, b, c, 0, 0, 0); }
__device__ __forceinline__ bf16x8 as_bf16x8(u32x4 v) { union { u32x4 u; bf16x8 b; } x; x.u = v; return x.b; }

#define XB_TMO      128
#define XB_XCNT(j)  (256  + 64 * (j))
#define XB_XSUB(j)  (1280 + 64 * (j))
#define XB_XGEN(j)  (2304 + 64 * (j))
#define XB_TOP      3328
#define XB_TOPGEN   3392
#define XB_SPIN_CAP (1u << 18)
__device__ __forceinline__ unsigned xb_ld(unsigned* p)              { return __hip_atomic_load(p, __ATOMIC_RELAXED, __HIP_MEMORY_SCOPE_AGENT); }
__device__ __forceinline__ unsigned xb_add(unsigned* p, unsigned v) { return __hip_atomic_fetch_add(p, v, __ATOMIC_RELAXED, __HIP_MEMORY_SCOPE_AGENT); }
__device__ __forceinline__ unsigned xb_xcc_id() { return (unsigned)__builtin_amdgcn_s_getreg((3 << 11) | 20) & 0xFu; }
#define XB_SPIN(cond, bar) do { unsigned _sp = 0; while (cond) { __builtin_amdgcn_s_sleep(1); \
    if ((++_sp & 255u) == 0u) { if (xb_ld(&(bar)[XB_TMO])) break; if (_sp > XB_SPIN_CAP) { atomicAdd(&(bar)[XB_TMO], 1u); break; } } } } while (0)
struct XcdBarrier { unsigned* bar; unsigned x; volatile LAS unsigned* st; };
__device__ __forceinline__ XcdBarrier xcd_barrier_post(unsigned* bar, volatile LAS unsigned* st) {
    XcdBarrier b; b.bar = bar; b.x = xb_xcc_id(); b.st = st;
    if (threadIdx.x == 0) (void)xb_add(&bar[XB_XCNT(b.x)], 1u);
    return b;
}
__device__ __forceinline__ void xcd_barrier_complete(unsigned* bar, unsigned x, unsigned& nloc, unsigned& nx) {
    const unsigned G = gridDim.x * gridDim.y * gridDim.z;
    unsigned sum, cnt, mine, sp = 0u;
    for (;;) {
        sum = 0u; cnt = 0u; mine = 0u;
#pragma unroll
        for (unsigned j = 0; j < 16; ++j) { const unsigned c = xb_ld(&bar[XB_XCNT(j)]); sum += c; cnt += (c > 0u) ? 1u : 0u; mine = (j == x) ? c : mine; }
        if (sum == G) break;
        __builtin_amdgcn_s_sleep(1);
        if ((++sp & 255u) == 0u) { if (xb_ld(&bar[XB_TMO])) break; if (sp > XB_SPIN_CAP) { atomicAdd(&bar[XB_TMO], 1u); break; } }
    }
    nloc = mine > 0u ? mine : 1u; nx = cnt > 0u ? cnt : 1u;
}
__device__ __forceinline__ void xcd_barrier(const XcdBarrier& b) {
    asm volatile("s_waitcnt vmcnt(0)" ::: "memory");
    __syncthreads();
    if (threadIdx.x == 0) {
        unsigned* bar = b.bar;
        __builtin_amdgcn_s_waitcnt(0);
        unsigned nloc = b.st[0], nx = b.st[1];
        if (nloc == 0u) { xcd_barrier_complete(bar, b.x, nloc, nx); b.st[0] = nloc; b.st[1] = nx; }
        const unsigned old = xb_add(&bar[XB_XSUB(b.x)], 1u);
        const unsigned gen = old / nloc;
        if (old + 1u == (gen + 1u) * nloc) {
            __builtin_amdgcn_fence(__ATOMIC_RELEASE, "agent");
            asm volatile("s_waitcnt vmcnt(0)" ::: "memory");
            const unsigned og = xb_add(&bar[XB_TOP], 1u);
            const unsigned tg = og / nx;
            if (og + 1u == (tg + 1u) * nx) xb_add(&bar[XB_TOPGEN], 1u);
            else XB_SPIN(xb_ld(&bar[XB_TOPGEN]) == tg, bar);
            __builtin_amdgcn_fence(__ATOMIC_ACQUIRE, "agent");
            xb_add(&bar[XB_XGEN(b.x)], 1u);
            asm volatile("s_waitcnt vmcnt(0)" ::: "memory");
        } else {
            XB_SPIN(xb_ld(&bar[XB_XGEN(b.x)]) == gen, bar);
            __builtin_amdgcn_fence(__ATOMIC_ACQUIRE, "agent");
            asm volatile("s_waitcnt vmcnt(0)" ::: "memory");
        }
    }
    __syncthreads();
}

namespace pg8 {
constexpr int BM = 256, BK = 64, HALF = 128, HTB = HALF * BK * 2, STAGE_BYTES = 8 * HTB, NXCD = 8, WGM = 8;
__host__ __device__ __forceinline__ int lds_byte(int r, int c) { const int st = (r >> 4) * 2 + (c >> 5), rr = r & 15, cc = c & 31, ob = rr * 64 + cc * 2; return st * 1024 + (ob ^ (((ob >> 9) & 1) << 5)); }
__host__ __device__ __forceinline__ void stage_rc(int b, int& R, int& C) { const int st = b / 1024, sb = b % 1024, swz = sb ^ (((sb >> 9) & 1) << 5); R = (st >> 1) * 16 + swz / 64; C = (st & 1) * 32 + (swz % 64) / 2; }
__host__ __device__ __forceinline__ int perm32(int rho) { const int n = rho >> 4, i = rho & 15; return 8 * (i >> 2) + 4 * n + (i & 3); }
struct Unit { int pm, pn; };
struct Gemm { const bf16_t* A; const bf16_t* Bt; int M, N, K; };
struct StaticOrder {
    int nM, nN, nwg, G, c;
    __device__ void init(int M, int N, int G_, int c_) { nM = M / BM; nN = N / BM; nwg = nM * nN; G = G_; c = c_; }
    __device__ bool next(int i, Unit& u) const {
        const long L = (long)i * G + c; if (L >= nwg) return false;
        int wgid = (int)L; { const int q = nwg / NXCD, r = nwg % NXCD, xcd = wgid % NXCD, off = wgid / NXCD; wgid = (xcd < r ? xcd * (q + 1) : r * (q + 1) + (xcd - r) * q) + off; }
        const int nig = WGM * nN, gid = wgid / nig, fm = gid * WGM, gsz = (nM - fm) < WGM ? (nM - fm) : WGM;
        u.pm = fm + ((wgid % nig) % gsz); u.pn = (wgid % nig) / gsz; return true;
    }
};

template <class Epi, bool ALIGN_EPI = true, bool SP2 = true>
__device__ __forceinline__ void gemm_phase(LAS unsigned char* lds, const Gemm g, const StaticOrder& S, const Epi& E) {
    const int tid = threadIdx.x, wid = __builtin_amdgcn_readfirstlane(tid >> 6), lane = tid & 63, wr = wid >> 2, wc = wid & 3, fr = lane & 15, fq = lane >> 4;
    const int K = g.K, nt = K / BK;
    unsigned voffA[2], voffB[2];
#pragma unroll
    for (int i = 0; i < 2; ++i) { int R, C; stage_rc(tid * 16 + i * 8192, R, C); const int Rb = Epi::PERM ? ((R & ~31) + perm32(R & 31)) : R;
        voffA[i] = (unsigned)(R * K + C) * 2u; voffB[i] = (unsigned)(Rb * K + C) * 2u; }
    const size_t kstep = (size_t)(BK * 2);
    const size_t hstep = (size_t)HALF * K * 2;
    const size_t tstep = 2 * hstep;
    const unsigned ldsw = (unsigned)wid * 1024u;
    const int aoff = lds_byte(wr * 64 + fr, fq * 8), boff = lds_byte(wc * 32 + fr, fq * 8);
#define PG8_SA(b, h) (((b) * 2 + (h)) * HTB)
#define PG8_SB(b, h) ((4 + (b) * 2 + (h)) * HTB)
#define PG8_STAGE(bufoff, gbase, voff) do { _Pragma("unroll") for (int _i = 0; _i < 2; ++_i) \
        __builtin_amdgcn_global_load_lds((const unsigned*)((const char*)(gbase) + (voff)[_i]), (LAS unsigned*)(lds + (bufoff) + ldsw + _i * 8192), 16, 0, 0); } while (0)
#define PG8_LDA(dst, b, h) do { _Pragma("unroll") for (int m = 0; m < 4; ++m) _Pragma("unroll") for (int k = 0; k < 2; ++k) dst[m][k] = *(const LAS bf16x8*)(lds + PG8_SA(b, h) + aoff + m * 2048 + k * 1024); } while (0)
#define PG8_LDB(dst, b, h) do { _Pragma("unroll") for (int n = 0; n < 2; ++n) _Pragma("unroll") for (int k = 0; k < 2; ++k) dst[n][k] = *(const LAS bf16x8*)(lds + PG8_SB(b, h) + boff + n * 2048 + k * 1024); } while (0)
#define PG8_MMA(ai, bj, At, Bt) do { __builtin_amdgcn_s_setprio(1); _Pragma("unroll") for (int m = 0; m < 4; ++m) _Pragma("unroll") for (int n = 0; n < 2; ++n) _Pragma("unroll") for (int k = 0; k < 2; ++k) \
        acc[ai][bj][m][n] = __builtin_amdgcn_mfma_f32_16x16x32_bf16(Bt[n][k], At[m][k], acc[ai][bj][m][n], 0, 0, 0); __builtin_amdgcn_s_setprio(0); } while (0)
#define PG8_WAIT_V(n) asm volatile("s_waitcnt vmcnt(" #n ")" ::: "memory")
#define PG8_WAIT_L(n) asm volatile("s_waitcnt lgkmcnt(" #n ")" ::: "memory")
#define PG8_BAR __builtin_amdgcn_s_barrier()
#define PG8_SCHED __builtin_amdgcn_sched_barrier(0)
    Unit cur, nxt; int ui = 0;
    if (!S.next(0, cur)) return;
    f32x4 acc[2][2][4][2];
#pragma unroll
    for (int a = 0; a < 2; ++a)
#pragma unroll
        for (int b = 0; b < 2; ++b)
#pragma unroll
            for (int m = 0; m < 4; ++m)
#pragma unroll
                for (int n = 0; n < 2; ++n) acc[a][b][m][n] = (f32x4){0.f, 0.f, 0.f, 0.f};
    bf16x8 At[4][2], B0[2][2], B1[2][2];
    const char* cA = (const char*)g.A + (size_t)cur.pm * tstep; const char* cB = (const char*)g.Bt + (size_t)cur.pn * tstep;
    if constexpr (SP2) {
        PG8_STAGE(PG8_SB(0, 0), cB, voffB); PG8_STAGE(PG8_SB(0, 1), cB + hstep, voffB); PG8_STAGE(PG8_SA(0, 0), cA, voffA); PG8_STAGE(PG8_SA(0, 1), cA + hstep, voffA);
        if (wr == 1) PG8_BAR;
        PG8_WAIT_V(2); PG8_BAR;
        PG8_STAGE(PG8_SB(1, 0), cB + kstep, voffB); PG8_STAGE(PG8_SA(1, 0), cA + kstep, voffA); PG8_STAGE(PG8_SB(1, 1), cB + hstep + kstep, voffB);
        PG8_WAIT_V(6); PG8_BAR;
    } else {
    PG8_STAGE(PG8_SB(0, 0), cB, voffB); PG8_STAGE(PG8_SA(0, 0), cA, voffA); PG8_STAGE(PG8_SB(0, 1), cB + hstep, voffB); PG8_STAGE(PG8_SA(0, 1), cA + hstep, voffA);
    if (wr == 1) PG8_BAR;
    PG8_WAIT_V(4); PG8_BAR;
    PG8_STAGE(PG8_SB(1, 0), cB + kstep, voffB); PG8_STAGE(PG8_SA(1, 0), cA + kstep, voffA); PG8_STAGE(PG8_SB(1, 1), cB + hstep + kstep, voffB);
    PG8_WAIT_V(6); PG8_BAR;
    }
    for (;;) {
        const bool has_next = S.next(ui + 1, nxt);
        const char* nA = has_next ? (const char*)g.A + (size_t)nxt.pm * tstep : cA; const char* nB = has_next ? (const char*)g.Bt + (size_t)nxt.pn * tstep : cB;
        for (int t = 0; t < nt; t += 2) {
            const bool last = (t == nt - 2);
            const char* a1 = cA + (size_t)(t + 1) * kstep;
            const char* a2 = last ? nA : cA + (size_t)(t + 2) * kstep; const char* b2 = last ? nB : cB + (size_t)(t + 2) * kstep;
            const char* a3 = a2 + kstep; const char* b3 = b2 + kstep;
            if constexpr (SP2) {
            PG8_LDB(B0, 0, 0); PG8_LDB(B1, 0, 1); PG8_SCHED; PG8_LDA(At, 0, 0); PG8_STAGE(PG8_SA(1, 1), a1 + hstep, voffA);
            PG8_WAIT_V(8); PG8_WAIT_L(0); PG8_BAR; PG8_MMA(0, 0, At, B0); PG8_MMA(0, 1, At, B1); PG8_BAR; PG8_SCHED;
            PG8_LDA(At, 0, 1); PG8_STAGE(PG8_SB(0, 0), b2, voffB); PG8_STAGE(PG8_SB(0, 1), b2 + hstep, voffB); PG8_STAGE(PG8_SA(0, 0), a2, voffA);
            PG8_WAIT_V(8); PG8_WAIT_L(0); PG8_BAR; PG8_MMA(1, 0, At, B0); PG8_MMA(1, 1, At, B1); PG8_BAR; PG8_SCHED;
            PG8_LDB(B0, 1, 0); PG8_LDB(B1, 1, 1); PG8_SCHED; PG8_LDA(At, 1, 0); PG8_STAGE(PG8_SA(0, 1), a2 + hstep, voffA);
            PG8_WAIT_V(8); PG8_WAIT_L(0); PG8_BAR; PG8_MMA(0, 0, At, B0); PG8_MMA(0, 1, At, B1); PG8_BAR; PG8_SCHED;
            PG8_LDA(At, 1, 1); PG8_STAGE(PG8_SB(1, 0), b3, voffB); PG8_STAGE(PG8_SB(1, 1), b3 + hstep, voffB); PG8_STAGE(PG8_SA(1, 0), a3, voffA);
            PG8_WAIT_V(8); PG8_WAIT_L(0); PG8_BAR; PG8_MMA(1, 0, At, B0); PG8_MMA(1, 1, At, B1); PG8_BAR; PG8_SCHED;
            } else {
            PG8_LDB(B0, 0, 0); PG8_SCHED; PG8_LDA(At, 0, 0); PG8_STAGE(PG8_SA(1, 1), a1 + hstep, voffA);
            PG8_WAIT_L(8); PG8_BAR; PG8_WAIT_L(0); PG8_MMA(0, 0, At, B0); PG8_BAR; PG8_SCHED;
            PG8_LDB(B1, 0, 1); PG8_STAGE(PG8_SB(0, 0), b2, voffB);
            PG8_BAR; PG8_WAIT_L(0); PG8_MMA(0, 1, At, B1); PG8_BAR;
            PG8_LDA(At, 0, 1); PG8_STAGE(PG8_SA(0, 0), a2, voffA);
            PG8_BAR; PG8_WAIT_L(0); PG8_MMA(1, 0, At, B0); PG8_BAR; PG8_SCHED;
            PG8_STAGE(PG8_SB(0, 1), b2 + hstep, voffB);
            PG8_WAIT_V(6); PG8_BAR; PG8_MMA(1, 1, At, B1); PG8_BAR;
            PG8_LDB(B0, 1, 0); PG8_SCHED; PG8_LDA(At, 1, 0); PG8_STAGE(PG8_SA(0, 1), a2 + hstep, voffA);
            PG8_WAIT_L(8); PG8_BAR; PG8_WAIT_L(0); PG8_MMA(0, 0, At, B0); PG8_BAR; PG8_SCHED;
            PG8_LDB(B1, 1, 1); PG8_STAGE(PG8_SB(1, 0), b3, voffB);
            PG8_BAR; PG8_WAIT_L(0); PG8_MMA(0, 1, At, B1); PG8_BAR;
            PG8_LDA(At, 1, 1); PG8_STAGE(PG8_SA(1, 0), a3, voffA);
            PG8_BAR; PG8_WAIT_L(0); PG8_MMA(1, 0, At, B0); PG8_BAR; PG8_SCHED;
            PG8_STAGE(PG8_SB(1, 1), b3 + hstep, voffB);
            PG8_WAIT_V(6); PG8_BAR; PG8_MMA(1, 1, At, B1); PG8_BAR;
            }
        }
        if constexpr (ALIGN_EPI) { if (wr == 0) PG8_BAR; }
        E(acc, cur, wr, wc, fr, fq);
        if (!has_next) break;
#pragma unroll
        for (int a = 0; a < 2; ++a)
#pragma unroll
            for (int b = 0; b < 2; ++b)
#pragma unroll
                for (int m = 0; m < 4; ++m)
#pragma unroll
                    for (int n = 0; n < 2; ++n) acc[a][b][m][n] = (f32x4){0.f, 0.f, 0.f, 0.f};
        cur = nxt; cA = nA; cB = nB; ++ui;
        if constexpr (ALIGN_EPI) { if (wr == 1) PG8_BAR; }
    }
    PG8_WAIT_V(0);
    if constexpr (!ALIGN_EPI) { if (wr == 0) PG8_BAR; }
    PG8_BAR;
#undef PG8_SA
#undef PG8_SB
#undef PG8_STAGE
#undef PG8_LDA
#undef PG8_LDB
#undef PG8_MMA
#undef PG8_WAIT_V
#undef PG8_WAIT_L
#undef PG8_BAR
#undef PG8_SCHED
}

struct EpiProj {
    static constexpr bool PERM = true;
    bf16_t* O; int ldc;
    __device__ __forceinline__ void operator()(const f32x4 (&acc)[2][2][4][2], const Unit& u, int wr, int wc, int fr, int fq) const {
        const int row0 = u.pm * BM + wr * 64 + fr, col0 = u.pn * BM + wc * 32 + 8 * fq;
#pragma unroll
        for (int ai = 0; ai < 2; ++ai)
#pragma unroll
            for (int m = 0; m < 4; ++m) { bf16_t* rowp = O + (size_t)(row0 + ai * HALF + m * 16) * ldc + col0;
#pragma unroll
                for (int bj = 0; bj < 2; ++bj) { const f32x4 v0 = acc[ai][bj][m][0], v1 = acc[ai][bj][m][1];
                    u32x4 w; w.x = pk_bf16(v0[0], v0[1]); w.y = pk_bf16(v0[2], v0[3]); w.z = pk_bf16(v1[0], v1[1]); w.w = pk_bf16(v1[2], v1[3]);
                    *(u32x4*)(rowp + bj * HALF) = w; } }
    }
};
}

__device__ __forceinline__ int map_win(int n) {
    if (n < 8192) return n;
    if (n < 13312) return n + 8;
    if (n < 15360) return n + 56;
    if (n < 15368) return n - 15360 + 8192;
    if (n < 15416) return n - 15368 + 13320;
    return -1;
}
template <bool WIN>
__device__ void transpose_cvt(const float* __restrict__ src, int src_ld, bf16_t* __restrict__ dst, int K, int ntn) {
    const int tid = threadIdx.x, lane = tid & 63, n4 = (lane & 15) * 4, k8 = (lane >> 4) * 8;
    const int nkt = K / 32, total = ntn * nkt, gw = blockIdx.x * 8 + (tid >> 6), nw = gridDim.x * 8;
    for (int it = gw; it < total; it += nw) {
        const int tn = it / nkt, tk = it - tn * nkt, n = tn * 64 + n4;
        const int sc = WIN ? map_win(n) : n;
        f32x4 v[8];
#pragma unroll
        for (int j = 0; j < 8; ++j) v[j] = (sc >= 0) ? *(const f32x4*)(src + (size_t)(tk * 32 + k8 + j) * src_ld + sc) : (f32x4){0.f, 0.f, 0.f, 0.f};
#pragma unroll
        for (int c = 0; c < 4; ++c) { u32x4 w; w.x = pk_bf16(v[0][c], v[1][c]); w.y = pk_bf16(v[2][c], v[3][c]); w.z = pk_bf16(v[4][c], v[5][c]); w.w = pk_bf16(v[6][c], v[7][c]);
            *(u32x4*)(dst + (size_t)(n + c) * K + tk * 32 + k8) = w; }
    }
}

__device__ void phase0(const Args& a, LAS unsigned char* lds) {
    const int tid = threadIdx.x, lane = tid & 63;
    unsigned char* ws = a.ws;
    {
        const int gw = ((tid >> 6) == 0) ? (int)blockIdx.x : 256;
        if (gw < 256) { const int kv = gw >> 7, e = gw & 127; const float* pos = kv ? a.in[10] : a.in[7]; const float* w1 = kv ? a.in[11] : a.in[8];
            float sacc = 0.f;
#pragma unroll 8
            for (int k = lane; k < 4096; k += 64) sacc += pos[k] * w1[(size_t)k * 128 + e];
            sacc = wave_sum(sacc);
            if (lane == 0) ((float*)(ws + WS_PB))[gw] = sacc; }
    }
    {
        const float* x = a.in[0]; const float* gain = a.in[1]; bf16_t* HB = (bf16_t*)(ws + WS_HB);
        const int gw = blockIdx.x * 8 + (tid >> 6), nw = gridDim.x * 8;
        for (int row = gw; row < MROWS; row += nw) {
            const f32x4* xr = (const f32x4*)(x + (size_t)row * D);
            f32x4 v[16]; float ss = 0.f;
#pragma unroll
            for (int i = 0; i < 16; ++i) { v[i] = xr[lane + 64 * i]; ss += (v[i][0] * v[i][0] + v[i][1] * v[i][1]) + (v[i][2] * v[i][2] + v[i][3] * v[i][3]); }
            ss = wave_sum(ss);
            const float rstd = 1.0f / sqrtf(ss * (1.0f / D) + 1e-6f);
#pragma unroll
            for (int i = 0; i < 16; ++i) { const f32x4 g = ((const f32x4*)gain)[lane + 64 * i];
                u32x2 w; w.x = pk_bf16(v[i][0] * rstd * g[0], v[i][1] * rstd * g[1]); w.y = pk_bf16(v[i][2] * rstd * g[2], v[i][3] * rstd * g[3]);
                *(u32x2*)(HB + (size_t)row * D + (lane + 64 * i) * 4) = w; }
        }
    }
    transpose_cvt<true>(a.in[2], W_IN_COLS, (bf16_t*)(ws + WS_WIN), D, NWIN / 64);
    transpose_cvt<false>(a.in[14], D, (bf16_t*)(ws + WS_WOUT), D, D / 64);
    transpose_cvt<false>(a.in[8], 128, (bf16_t*)(ws + WS_W1T), 4096, 2);
    transpose_cvt<false>(a.in[11], 128, (bf16_t*)(ws + WS_W1T) + 128 * 4096, 4096, 2);
    transpose_cvt<false>(a.in[9], 128, (bf16_t*)(ws + WS_W2T), 128, 2);
    transpose_cvt<false>(a.in[12], 128, (bf16_t*)(ws + WS_W2T) + 128 * 128, 128, 2);
}

__device__ void gate_gemm(const Args& a, LAS unsigned char* lds) {
    const int tid = threadIdx.x, lane = tid & 63, l16 = lane & 15, g4 = lane >> 4, wv = tid >> 6;
    const bf16_t* HB = (const bf16_t*)(a.ws + WS_HB); const bf16_t* WG = (const bf16_t*)(a.ws + WS_WIN) + (size_t)NP * D;
    float* GATES = (float*)(a.ws + WS_GATES);
    LAS float* part = (LAS float*)lds;
    for (int rb = blockIdx.x; rb < MROWS / 64; rb += gridDim.x) {
        const bf16_t* Ap = HB + (size_t)(rb * 64 + l16) * D + wv * 512 + g4 * 8;
        const bf16_t* Bp = WG + (size_t)l16 * D + wv * 512 + g4 * 8;
        f32x4 acc[4][4];
#pragma unroll
        for (int mt = 0; mt < 4; ++mt)
#pragma unroll
            for (int nt = 0; nt < 4; ++nt) acc[mt][nt] = (f32x4){0.f, 0.f, 0.f, 0.f};
#pragma unroll 2
        for (int ks = 0; ks < 16; ++ks) {
            bf16x8 af[4], bfr[4];
#pragma unroll
            for (int mt = 0; mt < 4; ++mt) af[mt] = *(const bf16x8*)(Ap + (size_t)mt * 16 * D + ks * 32);
#pragma unroll
            for (int nt = 0; nt < 4; ++nt) bfr[nt] = *(const bf16x8*)(Bp + (size_t)nt * 16 * D + ks * 32);
#pragma unroll
            for (int mt = 0; mt < 4; ++mt)
#pragma unroll
                for (int nt = 0; nt < 4; ++nt) acc[mt][nt] = mfma16(af[mt], bfr[nt], acc[mt][nt]);
        }
#pragma unroll
        for (int mt = 0; mt < 4; ++mt)
#pragma unroll
            for (int nt = 0; nt < 4; ++nt)
#pragma unroll
                for (int r = 0; r < 4; ++r) part[(wv * 64 + 16 * mt + 4 * g4 + r) * 68 + 16 * nt + l16] = acc[mt][nt][r];
        __syncthreads();
#pragma unroll
        for (int i = 0; i < 8; ++i) { const int idx = tid + 512 * i, row = idx >> 6, col = idx & 63; float sum = 0.f;
#pragma unroll
            for (int w8 = 0; w8 < 8; ++w8) sum += part[(w8 * 64 + row) * 68 + col];
            GATES[(size_t)(rb * 64 + row) * 64 + col] = sum; }
        __syncthreads();
    }
}

__device__ void phase2(const Args& a, LAS unsigned char* lds) {
    const int tid = threadIdx.x, lane = tid & 63, wv = tid >> 6, l16 = lane & 15, g4 = lane >> 4;
    unsigned char* ws = a.ws;
    const bf16_t* PROJ = (const bf16_t*)(ws + WS_PROJ);
    {
        const float* wconv = a.in[3]; bf16_t* QKC = (bf16_t*)(ws + WS_QKC); bf16_t* KT = (bf16_t*)(ws + WS_KT);
        LAS bf16_t* tl = (LAS bf16_t*)lds;
        for (int idx = blockIdx.x; idx < 4096; idx += gridDim.x) {
            const int cb = (idx + (idx >> 8)) & 15, rb = idx >> 4, row0 = rb * 64, t = tid >> 3, c16 = (tid & 7) * 16, ch = cb * 128 + c16;
            const int tin = (row0 & (T - 1)) + t;
            const bf16_t* src = PROJ + (size_t)(row0 + t) * NP + ch;
            float y[16];
#pragma unroll
            for (int e = 0; e < 16; ++e) y[e] = 0.f;
#pragma unroll
            for (int j = 0; j < 4; ++j) {
                if (tin - 3 + j >= 0) {
                    const u32x4 ua = *(const u32x4*)(src - (size_t)(3 - j) * NP), ub = *(const u32x4*)(src - (size_t)(3 - j) * NP + 8);
                    const float* wp = wconv + j * 2048 + ch;
                    const f32x4 w0 = *(const f32x4*)wp, w1 = *(const f32x4*)(wp + 4), w2 = *(const f32x4*)(wp + 8), w3 = *(const f32x4*)(wp + 12);
                    y[0] += w0[0] * bflo(ua[0]); y[1] += w0[1] * bfhi(ua[0]); y[2] += w0[2] * bflo(ua[1]); y[3] += w0[3] * bfhi(ua[1]);
                    y[4] += w1[0] * bflo(ua[2]); y[5] += w1[1] * bfhi(ua[2]); y[6] += w1[2] * bflo(ua[3]); y[7] += w1[3] * bfhi(ua[3]);
                    y[8] += w2[0] * bflo(ub[0]); y[9] += w2[1] * bfhi(ub[0]); y[10] += w2[2] * bflo(ub[1]); y[11] += w2[3] * bfhi(ub[1]);
                    y[12] += w3[0] * bflo(ub[2]); y[13] += w3[1] * bfhi(ub[2]); y[14] += w3[2] * bflo(ub[3]); y[15] += w3[3] * bfhi(ub[3]);
                }
            }
            const float osc = (cb >= 8) ? 0.0625f : 1.0f;
#pragma unroll
            for (int e = 0; e < 16; ++e) y[e] = siluf(y[e]) * osc;
            u32x4 o0, o1; o0.x = pk_bf16(y[0], y[1]); o0.y = pk_bf16(y[2], y[3]); o0.z = pk_bf16(y[4], y[5]); o0.w = pk_bf16(y[6], y[7]);
            o1.x = pk_bf16(y[8], y[9]); o1.y = pk_bf16(y[10], y[11]); o1.z = pk_bf16(y[12], y[13]); o1.w = pk_bf16(y[14], y[15]);
            bf16_t* dq = QKC + (size_t)(row0 + t) * 2048 + ch;
            *(u32x4*)dq = o0; *(u32x4*)(dq + 8) = o1;
            if (cb >= 8) {
                *(LAS u32x4*)(tl + t * 136 + c16) = o0; *(LAS u32x4*)(tl + t * 136 + c16 + 8) = o1;
                __syncthreads();
                const int d = tid >> 2, t16 = (tid & 3) * 16; unsigned e[16];
#pragma unroll
                for (int j = 0; j < 16; ++j) e[j] = tl[(t16 + j) * 136 + d];
                u32x4 w0, w1; w0.x = e[0] | (e[1] << 16); w0.y = e[2] | (e[3] << 16); w0.z = e[4] | (e[5] << 16); w0.w = e[6] | (e[7] << 16);
                w1.x = e[8] | (e[9] << 16); w1.y = e[10] | (e[11] << 16); w1.z = e[12] | (e[13] << 16); w1.w = e[14] | (e[15] << 16);
                bf16_t* dst = KT + ((size_t)(row0 >> 12) * 1024 + (cb - 8) * 128 + d) * T + (row0 & (T - 1)) + t16;
                *(u32x4*)dst = w0; *(u32x4*)(dst + 8) = w1;
                __syncthreads();
            }
        }
    }
    {
        LAS bf16_t* tl = (LAS bf16_t*)lds;
        for (int idx = blockIdx.x; idx < 2048; idx += gridDim.x) {
            const bf16_t* src; bf16_t* dst;
            if (idx < 2048) { const int which = idx >> 10, bg = (idx >> 6) & 15, tt = idx & 63, b = bg >> 2, g = bg & 3;
                src = PROJ + (size_t)(b * T + tt * 64) * NP + (which ? C_WV : C_SV) + g * 128;
                dst = (bf16_t*)(ws + (which ? WS_WVT : WS_SVT)) + (size_t)bg * 128 * T + tt * 64; }
#pragma unroll
            for (int i = 0; i < 2; ++i) { const int p = tid + 512 * i, t = p >> 4, d8 = (p & 15) * 8;
                *(LAS u32x4*)(tl + t * 136 + d8) = *(const u32x4*)(src + (size_t)t * NP + d8); }
            __syncthreads();
            { const int d = tid >> 2, t16 = (tid & 3) * 16; unsigned e[16];
#pragma unroll
              for (int j = 0; j < 16; ++j) e[j] = tl[(t16 + j) * 136 + d];
              u32x4 w0, w1; w0.x = e[0] | (e[1] << 16); w0.y = e[2] | (e[3] << 16); w0.z = e[4] | (e[5] << 16); w0.w = e[6] | (e[7] << 16);
              w1.x = e[8] | (e[9] << 16); w1.y = e[10] | (e[11] << 16); w1.z = e[12] | (e[13] << 16); w1.w = e[14] | (e[15] << 16);
              *(u32x4*)(dst + (size_t)d * T + t16) = w0; *(u32x4*)(dst + (size_t)d * T + t16 + 8) = w1; }
            __syncthreads();
        }
    }
    {
        LAS bf16_t* hid = (LAS bf16_t*)lds;
        LAS float* part = (LAS float*)(lds + 8192);
        const float* PB = (const float*)(ws + WS_PB);
        bf16_t* KC = (bf16_t*)(ws + WS_KC); bf16_t* VCT = (bf16_t*)(ws + WS_VCT);
        for (int item = blockIdx.x; item < 512; item += gridDim.x) {
            const int kv = item >> 8, bg = (item >> 4) & 15, ng = item & 15, b = bg >> 2, g = bg & 3;
            const bf16_t* W1 = (const bf16_t*)(ws + WS_W1T) + (size_t)kv * 128 * 4096; const bf16_t* W2 = (const bf16_t*)(ws + WS_W2T) + kv * 128 * 128;
            int n = ng * 16 + l16; if (n > 254) n = 254;
            const bf16_t* Ap = PROJ + (size_t)(b * T + 16 * n + 4 * wv) * NP + (kv ? C_CV : C_CK) + g * 128 + g4 * 8;
            const bf16_t* Bp = W1 + (size_t)l16 * 4096 + (4 * wv) * 128 + g4 * 8;
            f32x4 acc8[8];
#pragma unroll
            for (int et = 0; et < 8; ++et) acc8[et] = (f32x4){0.f, 0.f, 0.f, 0.f};
#pragma unroll 2
            for (int li = 0; li < 4; ++li)
#pragma unroll
                for (int dq = 0; dq < 4; ++dq) { const bf16x8 av = *(const bf16x8*)(Ap + (size_t)li * NP + dq * 32);
#pragma unroll
                    for (int et = 0; et < 8; ++et) acc8[et] = mfma16(av, *(const bf16x8*)(Bp + (size_t)et * 16 * 4096 + li * 128 + dq * 32), acc8[et]); }
#pragma unroll
            for (int et = 0; et < 8; ++et)
#pragma unroll
                for (int r = 0; r < 4; ++r) part[(wv * 16 + 4 * g4 + r) * 132 + 16 * et + l16] = acc8[et][r];
            __syncthreads();
            {
#pragma unroll
                for (int i = 0; i < 4; ++i) { const int idx = tid + 512 * i, row = idx >> 7, e = idx & 127; float sum = 0.f;
#pragma unroll
                    for (int w8 = 0; w8 < 8; ++w8) sum += part[(w8 * 16 + row) * 132 + e];
                    hid[row * 136 + e] = f2bf(siluf(sum + PB[kv * 128 + e])); }
            }
            __syncthreads();
            f32x4 acc2 = (f32x4){0.f, 0.f, 0.f, 0.f};
#pragma unroll
            for (int ks = 0; ks < 4; ++ks) acc2 = mfma16(*(const LAS bf16x8*)(hid + l16 * 136 + ks * 32 + g4 * 8), *(const bf16x8*)(W2 + (16 * wv + l16) * 128 + ks * 32 + g4 * 8), acc2);
            const int f = 16 * wv + l16, nb = ng * 16 + 4 * g4;
            float o[4];
#pragma unroll
            for (int r = 0; r < 4; ++r) o[r] = (nb + r < 255) ? acc2[r] : 0.f;
            if (kv == 0) {
#pragma unroll
                for (int r = 0; r < 4; ++r) KC[((size_t)bg * 256 + nb + r) * 128 + f] = f2bf(o[r]);
            } else { u32x2 w; w.x = pk_bf16(o[0], o[1]); w.y = pk_bf16(o[2], o[3]); *(u32x2*)(VCT + ((size_t)bg * 128 + f) * 256 + nb) = w; }
            __syncthreads();
        }
    }
}

__device__ __forceinline__ void mlstm_item(const Args& a, LAS unsigned char* lds, int item) {
    const int tid = threadIdx.x, lane = tid & 63, w = __builtin_amdgcn_readfirstlane(tid >> 6), l16 = lane & 15, g4 = lane >> 4;
    const int bh = item >> 4, sl = item & 15, b = bh >> 2, h = bh & 3;
    unsigned char* ws = a.ws;
    const bf16_t* PROJ = (const bf16_t*)(ws + WS_PROJ); const bf16_t* QKC = (const bf16_t*)(ws + WS_QKC); const float* GATES = (const float*)(ws + WS_GATES);
    bf16_t* HM = (bf16_t*)(ws + WS_HM); float* SS = (float*)(ws + WS_SS);
    LAS bf16_t* qs = (LAS bf16_t*)lds;
    LAS bf16_t* ks = qs + 64 * 264;
    LAS bf16_t* kT = ks + 64 * 264;
    LAS bf16_t* vT = kT + 256 * 72;
    LAS bf16_t* vTw = vT + 48 * 72;
    LAS bf16_t* CT = vTw + 48 * 72;
    LAS float* sc = (LAS float*)(CT + 48 * 264);
    LAS bf16_t* Pm = ks;
    for (int i = tid; i < 48 * 264; i += NTHREADS) CT[i] = 0;
    for (int i = tid; i < 16 * 72; i += NTHREADS) { const int r = i / 72; vT[(32 + r) * 72 + (i - r * 72)] = (r == 0) ? (bf16_t)0x3F80 : (bf16_t)0; vTw[(32 + r) * 72 + (i - r * 72)] = 0; }
    f32x4 Cacc[2][3];
#pragma unroll
    for (int i = 0; i < 2; ++i)
#pragma unroll
        for (int j = 0; j < 3; ++j) Cacc[i][j] = (f32x4){0.f, 0.f, 0.f, 0.f};
    float m_st = 0.f;
    const float bi = a.in[4][h], bfg = a.in[5][h];
    u32x4 qreg[4], kreg[4], ktreg[4], vreg; float gi = 0.f, gf = 0.f;
    const bf16_t* KT = (const bf16_t*)(ws + WS_KT) + ((size_t)b * 1024 + h * 256) * T;
    vreg = (u32x4){0, 0, 0, 0};
    const size_t rowbase = (size_t)b * T;
#define ML_PREFETCH(t0_) do { \
        _Pragma("unroll") for (int i = 0; i < 4; ++i) { const int p = tid + 512 * i, l = p >> 5, c8 = (p & 31) * 8; const bf16_t* s_ = QKC + (rowbase + (t0_) + l) * 2048 + h * 256 + c8; \
            qreg[i] = *(const u32x4*)s_; kreg[i] = *(const u32x4*)(s_ + 1024); \
            ktreg[i] = *(const u32x4*)(KT + (size_t)(p >> 3) * T + (t0_) + (p & 7) * 8); } \
        if (tid < 256) { const int l = tid >> 2, c8 = (tid & 3) * 8; vreg = *(const u32x4*)(PROJ + (rowbase + (t0_) + l) * NP + C_MV + h * 512 + sl * 32 + c8); } \
        if (tid < 64) { const float* gp = GATES + (rowbase + (t0_) + tid) * 64; gi = gp[h] + bi; gf = gp[4 + h] + bfg; } } while (0)
    ML_PREFETCH(0);
    __syncthreads();
    for (int c = 0; c < 64; ++c) {
        const int t0 = c * 64;
#pragma unroll
        for (int i = 0; i < 4; ++i) { const int p = tid + 512 * i, l = p >> 5, c8 = (p & 31) * 8;
            *(LAS u32x4*)(qs + l * 264 + c8) = qreg[i]; *(LAS u32x4*)(ks + l * 264 + c8) = kreg[i];
            *(LAS u32x4*)(kT + (p >> 3) * 72 + (p & 7) * 8) = ktreg[i]; }
        if (tid < 256) { const int l = tid >> 2, c8 = (tid & 3) * 8;
#pragma unroll
            for (int j = 0; j < 4; ++j) { vT[(c8 + 2 * j) * 72 + l] = (bf16_t)(vreg[j] & 0xffffu); vT[(c8 + 2 * j + 1) * 72 + l] = (bf16_t)(vreg[j] >> 16); } }
        if (w == 0) {
            const float lf = fminf(gf, 0.f) - log1pf(__expf(-fabsf(gf)));
            float bc = lf;
#pragma unroll
            for (int o = 1; o < 64; o <<= 1) { const float t = __shfl_up(bc, o); if (lane >= o) bc += t; }
            const float av = gi - bc; float pm = av;
#pragma unroll
            for (int o = 1; o < 64; o <<= 1) { const float t = __shfl_up(pm, o); if (lane >= o) pm = fmaxf(pm, t); }
            const float gtot = __shfl(bc, 63);
            const float mrow = fmaxf(m_st, pm), mr63 = __shfl(mrow, 63);
            sc[lane] = av; sc[64 + lane] = mrow; sc[128 + lane] = __expf(m_st - mrow); sc[192 + lane] = __expf(-(bc + mrow)); sc[256 + lane] = __expf(av - mr63);
            if (lane == 0) sc[320] = __expf(m_st - mr63);
            m_st = gtot + mr63;
        }
        if (c + 1 < 64) ML_PREFETCH(t0 + 64);
        __syncthreads();
        const int mt = w & 3, nq = w >> 2;
        unsigned ogr[4];
#pragma unroll
        for (int r = 0; r < 4; ++r) ogr[r] = PROJ[(rowbase + t0 + 16 * mt + 4 * g4 + r) * NP + C_MO + h * 512 + sl * 32 + 16 * nq + l16];
        f32x4 s0 = (f32x4){0.f, 0.f, 0.f, 0.f}, s1 = s0, ci0 = s0, ci2 = s0;
        {
            const LAS bf16_t* ap = qs + (16 * mt + l16) * 264 + g4 * 8;
            const LAS bf16_t* b0p = ks + (16 * (2 * nq) + l16) * 264 + g4 * 8;
            const LAS bf16_t* b1p = b0p + 16 * 264;
            const LAS bf16_t* c0p = CT + (16 * nq + l16) * 264 + g4 * 8;
            const LAS bf16_t* c2p = CT + (32 + l16) * 264 + g4 * 8;
            const bool do0 = (2 * nq <= mt), do1 = (2 * nq + 1 <= mt);
#pragma unroll
            for (int kq = 0; kq < 8; ++kq) {
                const bf16x8 av = *(const LAS bf16x8*)(ap + kq * 32);
                if (do0) s0 = mfma16(av, *(const LAS bf16x8*)(b0p + kq * 32), s0);
                if (do1) s1 = mfma16(av, *(const LAS bf16x8*)(b1p + kq * 32), s1);
                ci0 = mfma16(av, *(const LAS bf16x8*)(c0p + kq * 32), ci0);
                ci2 = mfma16(av, *(const LAS bf16x8*)(c2p + kq * 32), ci2);
            }
        }
        __syncthreads();
        {
#pragma unroll
            for (int r = 0; r < 4; ++r) { const int l = 16 * mt + 4 * g4 + r; const float mr = sc[64 + l];
                { const int s = 16 * (2 * nq) + l16; const float pv = (s <= l) ? s0[r] * __expf(sc[s] - mr) : 0.f; Pm[l * 72 + s] = f2bf(pv); }
                { const int s = 16 * (2 * nq + 1) + l16; const float pv = (s <= l) ? s1[r] * __expf(sc[s] - mr) : 0.f; Pm[l * 72 + s] = f2bf(pv); } }
#pragma unroll
            for (int i = 0; i < 5; ++i) { const int idx = tid + 512 * i; if (idx < 33 * 64) { const int row = idx >> 6, s = idx & 63; const float wt = sc[256 + s];
                vTw[row * 72 + s] = f2bf(row < 32 ? bf2f(vT[row * 72 + s]) * wt : wt); } }
        }
        __syncthreads();
        {
            f32x4 n0 = (f32x4){0.f, 0.f, 0.f, 0.f}, n2 = n0;
#pragma unroll
            for (int kq = 0; kq < 2; ++kq) { const bf16x8 av = *(const LAS bf16x8*)(Pm + (16 * mt + l16) * 72 + kq * 32 + g4 * 8);
                n0 = mfma16(av, *(const LAS bf16x8*)(vT + (16 * nq + l16) * 72 + kq * 32 + g4 * 8), n0);
                n2 = mfma16(av, *(const LAS bf16x8*)(vT + (32 + l16) * 72 + kq * 32 + g4 * 8), n2); }
            const int col = h * 512 + sl * 32 + 16 * nq + l16;
#pragma unroll
            for (int r = 0; r < 4; ++r) { const int l = 16 * mt + 4 * g4 + r; const float il = sc[128 + l];
                const float num = n0[r] + il * ci0[r]; float qn = n2[r] + il * ci2[r]; qn = __shfl(qn, lane & 48);
                const float den = fmaxf(fabsf(qn), sc[192 + l]);
                const size_t row = rowbase + t0 + l;
                const float og = sigm(bf2f(ogr[r]));
                const bf16_t hb = f2bf(og * num / den); HM[row * 2048 + col] = hb;
                float sq = bf2f(hb); sq *= sq;
                sq += __shfl_xor(sq, 1); sq += __shfl_xor(sq, 2); sq += __shfl_xor(sq, 4); sq += __shfl_xor(sq, 8);
                if (l16 == 0) SS[(row * 4 + h) * 32 + sl * 2 + nq] = sq; }
            const float keep = sc[320];
#pragma unroll
            for (int m2 = 0; m2 < 2; ++m2) {
#pragma unroll
                for (int j = 0; j < 3; ++j) Cacc[m2][j] *= keep;
#pragma unroll
                for (int kq = 0; kq < 2; ++kq) { const bf16x8 av = *(const LAS bf16x8*)(kT + (32 * w + 16 * m2 + l16) * 72 + kq * 32 + g4 * 8);
#pragma unroll
                    for (int j = 0; j < 3; ++j) Cacc[m2][j] = mfma16(av, *(const LAS bf16x8*)(vTw + (16 * j + l16) * 72 + kq * 32 + g4 * 8), Cacc[m2][j]); }
#pragma unroll
                for (int j = 0; j < 3; ++j) { u32x2 wv2; wv2.x = pk_bf16(Cacc[m2][j][0], Cacc[m2][j][1]); wv2.y = pk_bf16(Cacc[m2][j][2], Cacc[m2][j][3]);
                    *(LAS u32x2*)(CT + (16 * j + l16) * 264 + 32 * w + 16 * m2 + 4 * g4) = wv2; }
            }
        }
        __syncthreads();
    }
#undef ML_PREFETCH
}

struct TileDesc { const bf16_t* K; size_t kstr; const bf16_t* V; size_t vstr; int kp0, kstep, wlim, selj; };

constexpr float NEGL = -1e30f;
constexpr float QK_SC = 0.08838834764831845f * 1.4426950408889634f;

constexpr int TBN = 1088;
template <int MODE, int NTS>
__device__ __forceinline__ void nsa_tile(const LAS bf16_t* Kt, const LAS bf16_t* Vt, const LAS float* TB, const TileDesc& td, const bf16x8 (&qf)[2][4],
                                         const int (&tq)[2], const LAS unsigned long long* selm, int hh, int l16, int g4,
                                         f32x4 (&O)[8][2], float (&mrun)[2], float (&lrun)[2], const float (&invl)[2],
                                         LAS float* PA, LAS float* PBv, int w, int kt64, int t0, const bool MASKED) {
    const bool far = (t0 - (td.kp0 + 63 * td.kstep)) >= 790;
    const float bfar = TB[(1023 + 64) * 4 + hh];
    const bool alw0 = (td.selj < 0) || ((selm[0] >> td.selj) & 1ull), alw1 = (td.selj < 0) || ((selm[4] >> td.selj) & 1ull);
    constexpr bool any0 = (NTS & 1) != 0, any1 = (NTS & 2) != 0;
#pragma unroll 1
    for (int i = 0; i < 2; ++i) {
        f32x4 S[2][2];
#pragma unroll
        for (int mm = 0; mm < 2; ++mm) { S[mm][0] = (f32x4){0.f, 0.f, 0.f, 0.f}; S[mm][1] = S[mm][0]; }
#pragma unroll
        for (int mm = 0; mm < 2; ++mm) {
            bf16x8 kf[4];
#pragma unroll
            for (int kq = 0; kq < 4; ++kq) kf[kq] = *(const LAS bf16x8*)(Kt + (32 * i + 16 * mm + l16) * 136 + kq * 32 + g4 * 8);
            __builtin_amdgcn_sched_barrier(0);
#pragma unroll
            for (int kq = 0; kq < 4; ++kq) {
                if (any0) S[mm][0] = mfma16(kf[kq], qf[0][kq], S[mm][0]);
                if (any1) S[mm][1] = mfma16(kf[kq], qf[1][kq], S[mm][1]); }
            __builtin_amdgcn_sched_barrier(0);
        }
#pragma unroll
        for (int nt = 0; nt < 2; ++nt) {
            const bool allowed = nt ? alw1 : alw0;
            if (!(nt ? any1 : any0)) continue;
            float mx = NEGL;
            if (MASKED) {
#pragma unroll
                for (int mm = 0; mm < 2; ++mm)
#pragma unroll
                    for (int r = 0; r < 4; ++r) {
                        const int kk = 32 * i + 16 * mm + 4 * g4 + r, dist = tq[nt] - (td.kp0 + td.kstep * kk);
                        const bool ok = allowed && dist >= 0 && dist < td.wlim;
                        float bias = bfar;
                        if (!far) { int di = dist < -64 ? -64 : dist; di = di > 1023 ? 1023 : di; bias = TB[(di + 64) * 4 + hh]; }
                        const float lg = ok ? S[mm][nt][r] * QK_SC + bias : NEGL;
                        S[mm][nt][r] = lg; mx = fmaxf(mx, lg);
                    }
            } else {
                if (far) {
#pragma unroll
                    for (int mm = 0; mm < 2; ++mm)
#pragma unroll
                        for (int r = 0; r < 4; ++r) { const float lg = S[mm][nt][r] * QK_SC + bfar; S[mm][nt][r] = lg; mx = fmaxf(mx, lg); }
                } else {
                    const LAS float* tp = TB + ((tq[nt] - td.kp0 - 4 * g4 + 64 - 32 * i - 19) * 4 + hh);
#pragma unroll
                    for (int mm = 0; mm < 2; ++mm)
#pragma unroll
                        for (int r = 0; r < 4; ++r) { const float lg = S[mm][nt][r] * QK_SC + tp[(19 - 16 * mm - r) * 4]; S[mm][nt][r] = lg; mx = fmaxf(mx, lg); }
                }
                if (!allowed) mx = NEGL;
            }
            if (MODE != 1) {
                mx = colgroup_max(mx);
                const float mnew = fmaxf(mrun[nt], mx), alpha = __builtin_amdgcn_exp2f(mrun[nt] - mnew);
                mrun[nt] = mnew; float ps = 0.f;
#pragma unroll
                for (int mm = 0; mm < 2; ++mm)
#pragma unroll
                    for (int r = 0; r < 4; ++r) { const float lg = S[mm][nt][r];
                        const float p = MASKED ? ((lg <= -1e29f) ? 0.f : __builtin_amdgcn_exp2f(lg - mnew)) : (allowed ? __builtin_amdgcn_exp2f(lg - mnew) : 0.f);
                        S[mm][nt][r] = p; ps += p; }
                lrun[nt] = lrun[nt] * alpha + ps;
                if (MODE == 2) {
                    if (__builtin_amdgcn_ballot_w64(alpha != 1.0f) != 0ull) {
#pragma unroll
                        for (int dt = 0; dt < 8; ++dt) O[dt][nt] *= alpha;
                    }
                }
            } else {
                const float mfix = mrun[nt], il = invl[nt];
#pragma unroll
                for (int mm = 0; mm < 2; ++mm) {
#pragma unroll
                    for (int r = 0; r < 4; ++r) { const float lg = S[mm][nt][r]; S[mm][nt][r] = (lg <= -1e29f) ? 0.f : __builtin_amdgcn_exp2f(lg - mfix) * il; }
                    float pa = (S[mm][nt][0] + S[mm][nt][1]) + (S[mm][nt][2] + 0.5f * S[mm][nt][3]), pb = 0.5f * S[mm][nt][3];
                    pa += __shfl_xor(pa, 1); pa += __shfl_xor(pa, 2); pb += __shfl_xor(pb, 1); pb += __shfl_xor(pb, 2);
                    if ((l16 & 3) == 0) { const int tok = 8 * w + 4 * nt + (l16 >> 2), j = 16 * kt64 + 4 * (2 * i + mm) + g4; PA[tok * 65 + j] = pa; if (j + 1 < 64) PBv[tok * 65 + j + 1] = pb; }
                }
            }
        }
        if (MODE != 0) {
            bf16x8 pb[2];
#pragma unroll
            for (int nt = 0; nt < 2; ++nt) { u32x4 u; u.x = pk_bf16(S[0][nt][0], S[0][nt][1]); u.y = pk_bf16(S[0][nt][2], S[0][nt][3]);
                u.z = pk_bf16(S[1][nt][0], S[1][nt][1]); u.w = pk_bf16(S[1][nt][2], S[1][nt][3]); pb[nt] = as_bf16x8(u); }
#pragma unroll
            for (int dg = 0; dg < 2; ++dg) {
                bf16x8 vf[4];
#pragma unroll
                for (int d4 = 0; d4 < 4; ++d4) { const LAS bf16_t* vp = Vt + (16 * (4 * dg + d4) + l16) * 72 + 32 * i + 4 * g4;
                    const u32x2 lo = *(const LAS u32x2*)vp, hi = *(const LAS u32x2*)(vp + 16);
                    vf[d4] = as_bf16x8((u32x4){lo.x, lo.y, hi.x, hi.y}); }
                __builtin_amdgcn_sched_barrier(0);
#pragma unroll
                for (int d4 = 0; d4 < 4; ++d4) {
                    if (any0) O[4 * dg + d4][0] = mfma16(vf[d4], pb[0], O[4 * dg + d4][0]);
                    if (any1) O[4 * dg + d4][1] = mfma16(vf[d4], pb[1], O[4 * dg + d4][1]); }
                __builtin_amdgcn_sched_barrier(0);
            }
        }
    }
}

__device__ __forceinline__ void nsa_load(const TileDesc& td, int tid, u32x4 (&kr)[2], u32x4 (&vr)[2]) {
#pragma unroll
    for (int i = 0; i < 2; ++i) { const int p = tid + 512 * i;
        kr[i] = *(const u32x4*)(td.K + (size_t)(p >> 4) * td.kstr + (p & 15) * 8);
        vr[i] = *(const u32x4*)(td.V + (size_t)(p >> 3) * td.vstr + (p & 7) * 8); }
}
__device__ __forceinline__ void nsa_store(LAS bf16_t* Kb, LAS bf16_t* Vb, int tid, const u32x4 (&kr)[2], const u32x4 (&vr)[2]) {
#pragma unroll
    for (int i = 0; i < 2; ++i) { const int p = tid + 512 * i;
        *(LAS u32x4*)(Kb + (p >> 4) * 136 + (p & 15) * 8) = kr[i];
        *(LAS u32x4*)(Vb + (p >> 3) * 72 + (p & 7) * 8) = vr[i]; }
}

__device__ __forceinline__ void nsa_unit(const Args& a, LAS unsigned char* lds, int bg, int qb) {
    const int tid = threadIdx.x, lane = tid & 63, w = __builtin_amdgcn_readfirstlane(tid >> 6), l16 = lane & 15, g4 = lane >> 4;
    const int b = bg >> 2, g = bg & 3, t0 = qb * 64, hh = l16 & 3;
    unsigned char* ws = a.ws;
    const bf16_t* PROJ = (const bf16_t*)(ws + WS_PROJ); const float* GATES = (const float*)(ws + WS_GATES);
    LAS bf16_t* Kb0 = (LAS bf16_t*)lds;
    LAS bf16_t* Vb0 = Kb0 + 2 * 64 * 136;
    LAS float* TB = (LAS float*)(Vb0 + 2 * 128 * 72);
    LAS float* PA = TB + 4 * TBN;
    LAS float* PBv = PA + 64 * 65;
    LAS unsigned long long* SELM = (LAS unsigned long long*)(PBv + 64 * 65);
    LAS unsigned long long* UNI = SELM + 64;
    {
        const float* rel = a.in[13];
        for (int i = tid; i < 4 * TBN; i += NTHREADS) { const int h = i & 3, d = (i >> 2) - 64; int bk = d < 0 ? 0 : d;
            if (d >= 16) { bk = 16 + (d >= 21) + (d >= 27) + (d >= 35) + (d >= 46) + (d >= 59) + (d >= 77) + (d >= 99) + (d >= 128) + (d >= 166) + (d >= 216) + (d >= 280) + (d >= 363) + (d >= 470) + (d >= 609) + (d >= 790); }
            TB[i] = rel[bk * 16 + g * 4 + h] * 1.4426950408889634f; }
        for (int i = tid; i < 2 * 64 * 65; i += NTHREADS) PA[i] = 0.f;
    }
    int tq[2]; bf16x8 qf[2][4];
#pragma unroll
    for (int nt = 0; nt < 2; ++nt) { tq[nt] = t0 + 8 * w + 4 * nt + (l16 >> 2); const size_t row = (size_t)b * T + tq[nt];
        const bf16_t* qp = PROJ + row * NP + C_AQ + (g * 4 + hh) * 128 + g4 * 8;
#pragma unroll
        for (int kq = 0; kq < 4; ++kq) qf[nt][kq] = *(const bf16x8*)(qp + kq * 32);
 }
    f32x4 O[8][2];
    float mrun[2], lrun[2], invl[2] = {0.f, 0.f};
    const LAS unsigned long long* selm = SELM + 8 * w + (l16 >> 2);
    u32x4 kr[2], vr[2];
    TileDesc td;
#define O_ZERO() do { _Pragma("unroll") for (int dt = 0; dt < 8; ++dt) { O[dt][0] = (f32x4){0.f, 0.f, 0.f, 0.f}; O[dt][1] = O[dt][0]; } } while (0)
    const int ncmp = ((t0 + 32) >> 10) + 1 > 4 ? 4 : ((t0 + 32) >> 10) + 1;
    const bf16_t* KC = (const bf16_t*)(ws + WS_KC) + (size_t)bg * 256 * 128; const bf16_t* VCT = (const bf16_t*)(ws + WS_VCT) + (size_t)bg * 128 * 256;
    td.kstr = 128; td.vstr = 256; td.kstep = 16; td.wlim = 1 << 30; td.selj = -1;
    mrun[0] = mrun[1] = NEGL; lrun[0] = lrun[1] = 0.f;
    __syncthreads();
    for (int pass = 0; pass < 2; ++pass) {
        if (pass == 1) {
#pragma unroll
            for (int nt = 0; nt < 2; ++nt) { float l = lrun[nt]; l += __shfl_xor(l, 16); l += __shfl_xor(l, 32); invl[nt] = l > 0.f ? 1.0f / l : 0.f; }
            O_ZERO();
        }
        for (int kt = 0; kt < ncmp; ++kt) {
            td.K = KC + (size_t)kt * 64 * 128; td.V = VCT + kt * 64; td.kp0 = 1024 * kt + 31;
            nsa_load(td, tid, kr, vr); nsa_store(Kb0, Vb0, tid, kr, vr);
            __syncthreads();
            if (pass == 0) nsa_tile<0, 3>(Kb0, Vb0, TB, td, qf, tq, selm, hh, l16, g4, O, mrun, lrun, invl, PA, PBv, w, kt, t0, true);
            else nsa_tile<1, 3>(Kb0, Vb0, TB, td, qf, tq, selm, hh, l16, g4, O, mrun, lrun, invl, PA, PBv, w, kt, t0, true);
            __syncthreads();
        }
    }
    bf16_t* MIXA = (bf16_t*)(ws + WS_HB) + 2048 + (g * 4 + hh) * 128 + 4 * g4;
#pragma unroll
    for (int nt = 0; nt < 2; ++nt) { const float c = sigm(GATES[((size_t)b * T + tq[nt]) * 64 + 8 + (g * 4 + hh) * 3]); bf16_t* mp = MIXA + ((size_t)b * T + tq[nt]) * D;
#pragma unroll
        for (int dt = 0; dt < 8; ++dt) { u32x2 o; o.x = pk_bf16(O[dt][nt][0] * c, O[dt][nt][1] * c); o.y = pk_bf16(O[dt][nt][2] * c, O[dt][nt][3] * c); *(u32x2*)(mp + 16 * dt) = o; } }
    {
        unsigned long long uni = 0ull;
        const unsigned long long validmask = (qb >= 63) ? ~0ull : ((1ull << (qb + 1)) - 1ull);
        for (int ti = 0; ti < 8; ++ti) { const int tok = 8 * w + ti, j = lane;
            const bool valid = j <= qb, forced = (j == 0) || (j == qb) || (j == qb - 1);
            const float score = (PA[tok * 65 + j] + PBv[tok * 65 + j]) + (forced ? 1000.f : 0.f);
            const unsigned key = valid ? __float_as_uint(score) : 0u;
            unsigned thr = 0u;
#pragma unroll
            for (int bit = 31; bit >= 0; --bit) { const unsigned cand = thr | (1u << bit); if (__popcll(__ballot(key >= cand)) >= 16) thr = cand; }
            unsigned long long sel = __ballot(key > thr), eq = __ballot(key == thr);
            for (int need = 16 - __popcll(sel); need > 0; --need) { const unsigned long long b = eq & (0ull - eq); sel |= b; eq ^= b; }
            const unsigned long long msk = sel & validmask;
            if (lane == 0) SELM[tok] = msk;
            uni |= msk; }
        if (lane == 0) UNI[w] = uni;
    }
    __syncthreads();
    unsigned long long uni = 0ull;
#pragma unroll
    for (int i = 0; i < 8; ++i) uni |= UNI[i];
    for (int br = 1; br < 3; ++br) {
        unsigned long long rem;
        if (br == 1) { rem = uni; td.kstr = NP; td.vstr = T; td.kstep = 1; td.wlim = 1 << 30; }
        else { const int lo = qb >= 8 ? 0 : 8 - qb; rem = (0x1ffull >> lo) << lo; td.kstr = NP; td.vstr = T; td.kstep = 1; td.wlim = 512; td.selj = -1; }
        const bf16_t* Kbase = PROJ + (size_t)b * T * NP + (br == 1 ? C_SK : C_WK) + g * 128;
        const bf16_t* Vbase = (const bf16_t*)(ws + (br == 1 ? WS_SVT : WS_WVT)) + (size_t)bg * 128 * T;
        mrun[0] = mrun[1] = NEGL; lrun[0] = lrun[1] = 0.f; O_ZERO();
        int j = __builtin_ctzll(rem); rem &= rem - 1;
        { const int s0 = (br == 1) ? 64 * j : t0 - 512 + 64 * j; td.K = Kbase + (size_t)s0 * NP; td.V = Vbase + s0; td.kp0 = s0; if (br == 1) td.selj = j; }
        nsa_load(td, tid, kr, vr); nsa_store(Kb0, Vb0, tid, kr, vr);
        __syncthreads();
        int buf = 0;
        for (;;) {
            const int jn = rem ? __builtin_ctzll(rem) : -1;
            TileDesc tn = td;
            if (jn >= 0) { const int s0 = (br == 1) ? 64 * jn : t0 - 512 + 64 * jn; tn.K = Kbase + (size_t)s0 * NP; tn.V = Vbase + s0; tn.kp0 = s0; if (br == 1) tn.selj = jn; nsa_load(tn, tid, kr, vr); }
            const bool msk = (br == 1) ? (j == qb) : (j == 0 || j == 8);
            {
                const bool a0 = (td.selj < 0) || ((selm[0] >> td.selj) & 1ull), a1 = (td.selj < 0) || ((selm[4] >> td.selj) & 1ull);
                const bool any0 = __builtin_amdgcn_ballot_w64(a0) != 0ull, any1 = __builtin_amdgcn_ballot_w64(a1) != 0ull;
                const LAS bf16_t* kb = Kb0 + buf * 64 * 136; const LAS bf16_t* vb = Vb0 + buf * 128 * 72;
                if (any0 || any1) nsa_tile<2, 3>(kb, vb, TB, td, qf, tq, selm, hh, l16, g4, O, mrun, lrun, invl, PA, PBv, w, 0, t0, msk);
            }
            if (jn >= 0) nsa_store(Kb0 + (buf ^ 1) * 64 * 136, Vb0 + (buf ^ 1) * 128 * 72, tid, kr, vr);
            __syncthreads();
            if (jn < 0) break;
            rem &= rem - 1; td = tn; buf ^= 1; j = jn;
        }
#pragma unroll
        for (int nt = 0; nt < 2; ++nt) { float l = lrun[nt]; l += __shfl_xor(l, 16); l += __shfl_xor(l, 32); const size_t row = (size_t)b * T + tq[nt]; bf16_t* mp = MIXA + row * D;
            const float gsel = sigm(GATES[row * 64 + 8 + (g * 4 + hh) * 3 + br]); const float c = l > 0.f ? gsel / l : 0.f;
#pragma unroll
            for (int dt = 0; dt < 8; ++dt) { const u32x2 prev = *(const u32x2*)(mp + 16 * dt);
                const float o0 = bflo(prev.x) + O[dt][nt][0] * c, o1 = bfhi(prev.x) + O[dt][nt][1] * c, o2 = bflo(prev.y) + O[dt][nt][2] * c, o3 = bfhi(prev.y) + O[dt][nt][3] * c;
                u32x2 o;
                if (br == 1) { o.x = pk_bf16(o0, o1); o.y = pk_bf16(o2, o3); }
                else { const u32x2 z = *(const u32x2*)(PROJ + row * NP + C_AZ + (g * 4 + hh) * 128 + 16 * dt + 4 * g4);
                    o.x = pk_bf16(o0 * siluf(bflo(z.x)), o1 * siluf(bfhi(z.x))); o.y = pk_bf16(o2 * siluf(bflo(z.y)), o3 * siluf(bfhi(z.y))); }
                *(u32x2*)(mp + 16 * dt) = o; } }
    }
    __syncthreads();
#undef O_ZERO
}

__device__ void phase4(const Args& a) {
    const int tid = threadIdx.x, lane = tid & 63;
    unsigned char* ws = a.ws;
    const bf16_t* PROJ = (const bf16_t*)(ws + WS_PROJ); const bf16_t* HM = (const bf16_t*)(ws + WS_HM); const float* SS = (const float*)(ws + WS_SS);
    bf16_t* MIX = (bf16_t*)(ws + WS_HB); const float* gain = a.in[6];
    const int gw = blockIdx.x * 8 + (tid >> 6), nw = gridDim.x * 8;
    for (int it = gw; it < MROWS * 4; it += nw) {
        const int row = it >> 2, h = it & 3, c8 = h * 512 + lane * 8;
        const u32x4 hv = *(const u32x4*)(HM + (size_t)row * 2048 + c8), zv = *(const u32x4*)(PROJ + (size_t)row * NP + C_MZ + c8);
        const float sp = SS[(size_t)it * 32 + (lane & 31)];
        float s = sp; s += __shfl_xor(s, 1); s += __shfl_xor(s, 2); s += __shfl_xor(s, 4); s += __shfl_xor(s, 8); s += __shfl_xor(s, 16);
        const float rstd = 1.0f / sqrtf(s * (1.0f / 512.f) + 1e-6f);
        const f32x4 g0 = *(const f32x4*)(gain + c8), g1 = *(const f32x4*)(gain + c8 + 4);
        u32x4 o;
        o.x = pk_bf16(bflo(hv.x) * rstd * g0[0] * siluf(bflo(zv.x)), bfhi(hv.x) * rstd * g0[1] * siluf(bfhi(zv.x)));
        o.y = pk_bf16(bflo(hv.y) * rstd * g0[2] * siluf(bflo(zv.y)), bfhi(hv.y) * rstd * g0[3] * siluf(bfhi(zv.y)));
        o.z = pk_bf16(bflo(hv.z) * rstd * g1[0] * siluf(bflo(zv.z)), bfhi(hv.z) * rstd * g1[1] * siluf(bfhi(zv.z)));
        o.w = pk_bf16(bflo(hv.w) * rstd * g1[2] * siluf(bflo(zv.w)), bfhi(hv.w) * rstd * g1[3] * siluf(bfhi(zv.w)));
        *(u32x4*)(MIX + (size_t)row * D + c8) = o;
    }
}

__device__ void phase6(const Args& a) {
    const int tid = threadIdx.x, lane = tid & 63;
    float* out = a.out; const float* x = a.in[0]; const float* gain = a.in[15];
    const int gw = blockIdx.x * 8 + (tid >> 6), nw = gridDim.x * 8;
    for (int row = gw; row < MROWS; row += nw) {
        f32x4* orow = (f32x4*)(out + (size_t)row * D); const f32x4* xr = (const f32x4*)(x + (size_t)row * D);
        const u32x2* pr = (const u32x2*)((const bf16_t*)(a.ws + WS_PROJ) + (size_t)row * D);
        f32x4 v[16]; float ss = 0.f;
#pragma unroll
        for (int i = 0; i < 16; ++i) { const u32x2 pv = pr[lane + 64 * i]; const f32x4 xv = xr[lane + 64 * i];
            v[i][0] = bflo(pv.x) + xv[0]; v[i][1] = bfhi(pv.x) + xv[1]; v[i][2] = bflo(pv.y) + xv[2]; v[i][3] = bfhi(pv.y) + xv[3];
            ss += (v[i][0] * v[i][0] + v[i][1] * v[i][1]) + (v[i][2] * v[i][2] + v[i][3] * v[i][3]); }
        ss = wave_sum(ss);
        const float rstd = 1.0f / sqrtf(ss * (1.0f / D) + 1e-6f);
#pragma unroll
        for (int i = 0; i < 16; ++i) { const f32x4 g = ((const f32x4*)gain)[lane + 64 * i]; f32x4 o;
            o[0] = v[i][0] * rstd * g[0]; o[1] = v[i][1] * rstd * g[1]; o[2] = v[i][2] * rstd * g[2]; o[3] = v[i][3] * rstd * g[3]; orow[lane + 64 * i] = o; }
    }
}

__global__ void __launch_bounds__(NTHREADS, 2) hymba_fwd(Args a) {
    extern __shared__ __attribute__((aligned(16))) unsigned char lds_raw[];
    LAS unsigned char* lds = (LAS unsigned char*)lds_raw;
    cg::grid_group grid = cg::this_grid();
    volatile LAS unsigned* xb_st = (volatile LAS unsigned*)(lds + (LDS_BYTES - 16));
    if (threadIdx.x < 4) xb_st[threadIdx.x] = 0u;
    __syncthreads();
    unsigned* xb_words = (unsigned*)(a.ws + WS_BAR);
    XcdBarrier xbar; xbar.bar = xb_words; xbar.x = 0u; xbar.st = xb_st;
    const int lo = a.ph_lo, hi = a.ph_hi;
#ifdef STAMP_SEL
    unsigned long long* stamps = (unsigned long long*)(a.ws + WS_END2);
#define STAMP(k) do { if (blockIdx.x == 0 && threadIdx.x == 0) stamps[k] = __builtin_amdgcn_s_memrealtime(); } while (0)
#else
#define STAMP(k) do { } while (0)
#endif
    STAMP(0);
#ifndef PH_MASK
#define PH_MASK 0x7f
#endif
#define IN(k) (((PH_MASK >> (k)) & 1) && lo <= (k) && (k) < hi)
#define SEAM(k) do { if ((k) + 1 < hi) { if ((k) == 0) { asm volatile("s_waitcnt vmcnt(0)" ::: "memory"); grid.sync(); xbar = xcd_barrier_post(xb_words, xb_st); } else xcd_barrier(xbar); } } while (0)
    if (IN(0)) { if (blockIdx.x == 0) for (int i = threadIdx.x; i < XCD_BAR_WORDS; i += NTHREADS) xb_words[i] = 0u;
        for (int rep = 0; rep < REP_P0; ++rep) phase0(a, lds); SEAM(0); STAMP(1); }
    if (IN(1)) { for (int rep = 0; rep < REP_P1; ++rep) {
        pg8::Gemm g{(const bf16_t*)(a.ws + WS_HB), (const bf16_t*)(a.ws + WS_WIN), MROWS, NP, D};
        pg8::StaticOrder S; S.init(MROWS, NP, gridDim.x, blockIdx.x);
        pg8::EpiProj E{(bf16_t*)(a.ws + WS_PROJ), NP};
        pg8::gemm_phase<pg8::EpiProj>(lds, g, S, E);
        gate_gemm(a, lds); }
        SEAM(1); STAMP(2);
    }
    if (IN(2)) { for (int rep = 0; rep < REP_P2; ++rep) phase2(a, lds); SEAM(2); STAMP(3); }
    if (IN(3)) {
#ifndef NO_MLSTM
        for (int rep = 0; rep < REP_ML; ++rep)
        for (int it0 = blockIdx.x; it0 < 256; it0 += gridDim.x) {
            const int item = (gridDim.x == 256) ? (((it0 & 7) * 2 + (it0 >> 7)) * 16 + ((it0 >> 3) & 15)) : it0;
            mlstm_item(a, lds, item); }
#endif
        __syncthreads();
        STAMP(4);
#ifndef NO_NSA
        for (int rep = 0; rep < REP_NSA; ++rep)
        for (int p2 = blockIdx.x * 2; p2 < 1024; p2 += gridDim.x * 2)
            for (int u = 0; u < 2; ++u) { const int p = p2 >> 1, bg = p & 15, qq = p >> 4; nsa_unit(a, lds, bg, u ? qq : 63 - qq); }
#endif
        SEAM(3); STAMP(5);
    }
    if (IN(4)) { phase4(a); SEAM(4); STAMP(6); }
    if (IN(5)) { for (int rep = 0; rep < REP_P5; ++rep) {
        pg8::Gemm g{(const bf16_t*)(a.ws + WS_HB), (const bf16_t*)(a.ws + WS_WOUT), MROWS, D, D};
        pg8::StaticOrder S; S.init(MROWS, D, gridDim.x, blockIdx.x);
        pg8::EpiProj E{(bf16_t*)(a.ws + WS_PROJ), D};
        pg8::gemm_phase<pg8::EpiProj>(lds, g, S, E); }
        SEAM(5); STAMP(7);
    }
    if (IN(6)) { phase6(a); }
#ifdef STAMP_SEL
    __builtin_amdgcn_fence(__ATOMIC_RELEASE, "agent"); grid.sync(); __builtin_amdgcn_fence(__ATOMIC_ACQUIRE, "agent");
    if (blockIdx.x == 0) { STAMP(8); __syncthreads();
        const unsigned long long k = stamps[STAMP_SEL + 1] - stamps[STAMP_SEL];
        for (unsigned long long i = threadIdx.x; i < k; i += NTHREADS) a.out[i] += 0.0625f; }
#endif
#undef IN
#undef SEAM
}

extern "C" void kernel_launch(void* const* d_in, const int* in_sizes, int n_in, void* d_out, int out_size, void* d_ws, size_t ws_size, hipStream_t stream) {
    static int grid = 0;
    if (grid == 0) {
        if (n_in != 16 || ws_size < WS_END3) { fprintf(stderr, "kernel_launch: bad inputs (n_in %d, ws %zu, need %zu)\n", n_in, ws_size, (size_t)WS_END); grid = -1; return; }
        int dev = 0, cus = 0, per_cu = 0;
        (void)hipGetDevice(&dev);
        (void)hipDeviceGetAttribute(&cus, hipDeviceAttributeMultiprocessorCount, dev);
        if (hipFuncSetAttribute((const void*)hymba_fwd, hipFuncAttributeMaxDynamicSharedMemorySize, LDS_BYTES) != hipSuccess) { fprintf(stderr, "kernel_launch: hipFuncSetAttribute failed\n"); grid = -1; return; }
        if (hipOccupancyMaxActiveBlocksPerMultiprocessor(&per_cu, (const void*)hymba_fwd, NTHREADS, LDS_BYTES) != hipSuccess || per_cu < 1) { fprintf(stderr, "kernel_launch: occupancy query says %d\n", per_cu); per_cu = 1; }
        (void)hipGetLastError();
        grid = cus * 1;
    }
    if (grid < 0) return;
    Args a{};
    for (int i = 0; i < 16; ++i) a.in[i] = (const float*)d_in[i];
    a.out = (float*)d_out; a.ws = (unsigned char*)d_ws;
#if N_LAUNCH_SPLIT
    for (int ph = 0; ph < 7; ++ph) { a.ph_lo = ph; a.ph_hi = ph + 1; hipLaunchKernelGGL(hymba_fwd, dim3(grid), dim3(NTHREADS), LDS_BYTES, stream, a); }
#else
    a.ph_lo = 0; a.ph_hi = 7;
    void* args[] = {&a};
    hipError_t e = hipLaunchCooperativeKernel((const void*)hymba_fwd, dim3(grid), dim3(NTHREADS), args, LDS_BYTES, stream);
    if (e != hipSuccess) fprintf(stderr, "cooperative launch failed: %s (grid %d)\n", hipGetErrorString(e), grid);
#endif
}
```
